# Optimizing an MI355X kernel written in HIP

```python
import math
import jax, jax.numpy as jnp
from jax import lax
import numpy as np

D_MODEL = 1024
BATCH = 4
SEQ = 8192
DEPTH = 1

HEAD_DIM = 64
DSA_HEADS = 8
IDX_HEADS = 8
IDX_DIM = 64
TOPK_MAX = 256
SWA_HEADS = 8
SWA_KV_HEADS = 2
WINDOW = 128
BLOCK = 128
MEM_TOKENS = 256
MEM_HEADS = 4
MEM_HEAD_DIM = D_MODEL // MEM_HEADS
D_MIX = (DSA_HEADS + SWA_HEADS) * HEAD_DIM
D_FF = 4 * D_MODEL
ROPE_THETA = 10000.0
LN_EPS = 1e-5
DEEPNORM_ALPHA = (2.0 * DEPTH) ** 0.25
DEEPNORM_BETA = (8.0 * DEPTH) ** -0.25
IN_SIZES = (DSA_HEADS * HEAD_DIM, HEAD_DIM, HEAD_DIM,
            IDX_HEADS * IDX_DIM, IDX_DIM, IDX_HEADS,
            SWA_HEADS * HEAD_DIM, SWA_KV_HEADS * HEAD_DIM, SWA_KV_HEADS * HEAD_DIM)
IN_COLS = sum(IN_SIZES)

kernel_name = "hymba_dsa_swa_sink_deepnorm_layer"


def layer_norm(x, g, b):
    xf = x.astype(jnp.float32)
    mu = jnp.mean(xf, axis=-1, keepdims=True)
    var = jnp.mean(jnp.square(xf - mu), axis=-1, keepdims=True)
    y = (xf - mu) * lax.rsqrt(var + LN_EPS)
    return (y * g.astype(jnp.float32) + b.astype(jnp.float32)).astype(x.dtype)


def rope_tables(positions, dim):
    inv = ROPE_THETA ** (-jnp.arange(0, dim, 2, dtype=jnp.float32) / dim)
    ang = positions.astype(jnp.float32)[..., None] * inv
    return jnp.cos(ang), jnp.sin(ang)


def apply_rope(x, cos, sin):
    half = x.shape[-1] // 2
    xf = x.astype(jnp.float32)
    x1, x2 = xf[..., :half], xf[..., half:]
    c, s = cos[:, :, None, :], sin[:, :, None, :]
    return jnp.concatenate([x1 * c - x2 * s, x2 * c + x1 * s], axis=-1).astype(x.dtype)


def dsa_sparse_attention(q, k, v, iq, ik, iw):
    B, S, H, dh = q.shape
    n_sel = min(TOPK_MAX, S // 4)
    nb = S // BLOCK
    key_pos = jnp.arange(S)
    scale = HEAD_DIM ** -0.5
    idx_scale = (IDX_DIM ** -0.5) * (IDX_HEADS ** -0.5)

    def to_blocks(a):
        return jnp.moveaxis(a.reshape((B, nb, BLOCK) + a.shape[2:]), 1, 0)

    def one_block(args):
        qb, iqb, iwb, start = args
        qpos = start + jnp.arange(BLOCK)
        causal = key_pos[None, :] <= qpos[:, None]
        rel = jax.nn.relu(jnp.einsum('bthd,bsd->bths', iqb, ik).astype(jnp.float32))
        score = jnp.einsum('bths,bth->bts', rel, iwb.astype(jnp.float32)) * idx_scale
        score = jnp.where(causal[None], score, -jnp.inf)
        _, sel = lax.top_k(score, n_sel)
        valid = sel <= qpos[None, :, None]
        k_sel = jax.vmap(lambda kb, ib: kb[ib])(k, sel)
        v_sel = jax.vmap(lambda vb, ib: vb[ib])(v, sel)
        logits = jnp.einsum('bthd,btnd->bthn', qb, k_sel).astype(jnp.float32) * scale
        logits = jnp.where(valid[:, :, None, :], logits, -jnp.inf)
        p = jax.nn.softmax(logits, axis=-1).astype(v.dtype)
        return jnp.einsum('bthn,btnd->bthd', p, v_sel)

    starts = jnp.arange(nb) * BLOCK
    out = lax.map(one_block, (to_blocks(q), to_blocks(iq), to_blocks(iw), starts))
    return jnp.moveaxis(out, 0, 1).reshape(B, S, H * dh)


def swa_sink_attention(q, k, v, sinks):
    B, S, Hq, dh = q.shape
    Hkv = k.shape[2]
    G = Hq // Hkv
    nb = S // BLOCK
    scale = dh ** -0.5
    qb = q.reshape(B, nb, BLOCK, Hkv, G, dh)

    def band(a):
        ab = a.reshape(B, nb, BLOCK, Hkv, dh)
        prev = jnp.pad(ab, ((0, 0), (1, 0), (0, 0), (0, 0), (0, 0)))[:, :-1]
        return jnp.concatenate([prev, ab], axis=2)

    kb, vb = band(k), band(v)
    qpos = jnp.arange(BLOCK)[:, None] + BLOCK
    kpos = jnp.arange(2 * BLOCK)[None, :]
    diff = qpos - kpos
    inband = (diff >= 0) & (diff < WINDOW)
    first = (jnp.arange(nb)[:, None, None] == 0) & (kpos[None] < BLOCK)
    valid = inband[None] & jnp.logical_not(first)
    logits = jnp.einsum('bnqhgd,bnkhd->bnhgqk', qb, kb).astype(jnp.float32) * scale
    logits = jnp.where(valid[None, :, None, None], logits, -jnp.inf)
    sink = jnp.broadcast_to(sinks.astype(jnp.float32).reshape(1, 1, Hkv, G, 1, 1),
                            logits.shape[:-1] + (1,))
    p = jax.nn.softmax(jnp.concatenate([logits, sink], axis=-1), axis=-1)[..., :-1]
    out = jnp.einsum('bnhgqk,bnkhd->bnqhgd', p.astype(v.dtype), vb)
    return out.reshape(B, S, Hq * dh)


def memory_cross_attention(x, mem, wq, wk, wv, wo):
    B, S, _ = x.shape
    M = mem.shape[1]
    q = (x @ wq).reshape(B, S, MEM_HEADS, MEM_HEAD_DIM)
    k = (mem @ wk).reshape(B, M, MEM_HEADS, MEM_HEAD_DIM)
    v = (mem @ wv).reshape(B, M, MEM_HEADS, MEM_HEAD_DIM)
    logits = jnp.einsum('bshd,bmhd->bhsm', q, k).astype(jnp.float32) * (MEM_HEAD_DIM ** -0.5)
    p = jax.nn.softmax(logits, axis=-1).astype(v.dtype)
    o = jnp.einsum('bhsm,bmhd->bshd', p, v).reshape(B, S, MEM_HEADS * MEM_HEAD_DIM)
    return o @ wo


def squared_relu_mlp(x, w_up, w_down):
    return jnp.square(jax.nn.relu(x @ w_up)) @ w_down


def setup_inputs(seed: int = 0) -> dict:
    key = jax.random.key(seed)
    ks = jax.random.split(key, 20)
    f32 = jnp.float32
    n = lambda k, shape, s: jax.random.normal(k, shape, f32) * s
    x = n(ks[0], (BATCH, SEQ, D_MODEL), 1.0)
    mem = n(ks[1], (BATCH, MEM_TOKENS, D_MODEL), 1.0)
    positions = jnp.broadcast_to(jnp.arange(SEQ, dtype=jnp.int32)[None, :], (BATCH, SEQ))
    return {
        "x": x,
        "mem": mem,
        "positions": positions,
        "w_in": n(ks[2], (DEPTH, D_MODEL, IN_COLS), D_MODEL ** -0.5),
        "b_in": n(ks[3], (DEPTH, IN_COLS), 0.01),
        "swa_sinks": n(ks[4], (DEPTH, SWA_HEADS), 0.5),
        "w_o": n(ks[5], (DEPTH, D_MIX, D_MODEL), D_MIX ** -0.5 * DEEPNORM_BETA),
        "ln1_g": 1.0 + n(ks[6], (DEPTH, D_MODEL), 0.02),
        "ln1_b": n(ks[7], (DEPTH, D_MODEL), 0.02),
        "wq_mem": n(ks[8], (DEPTH, D_MODEL, D_MODEL), D_MODEL ** -0.5),
        "wk_mem": n(ks[9], (DEPTH, D_MODEL, D_MODEL), D_MODEL ** -0.5),
        "wv_mem": n(ks[10], (DEPTH, D_MODEL, D_MODEL), D_MODEL ** -0.5),
        "wo_mem": n(ks[11], (DEPTH, D_MODEL, D_MODEL), D_MODEL ** -0.5 * DEEPNORM_BETA),
        "ln2_g": 1.0 + n(ks[12], (DEPTH, D_MODEL), 0.02),
        "ln2_b": n(ks[13], (DEPTH, D_MODEL), 0.02),
        "w_up": n(ks[14], (DEPTH, D_MODEL, D_FF), D_MODEL ** -0.5 * DEEPNORM_BETA),
        "w_down": n(ks[15], (DEPTH, D_FF, D_MODEL), D_FF ** -0.5 * DEEPNORM_BETA),
        "ln3_g": 1.0 + n(ks[16], (DEPTH, D_MODEL), 0.02),
        "ln3_b": n(ks[17], (DEPTH, D_MODEL), 0.02),
    }


def reference(x, mem, positions, w_in, b_in, swa_sinks, w_o, ln1_g, ln1_b,
              wq_mem, wk_mem, wv_mem, wo_mem, ln2_g, ln2_b,
              w_up, w_down, ln3_g, ln3_b):
    B, S, _ = x.shape
    cos, sin = rope_tables(positions, HEAD_DIM)
    offsets = np.cumsum(IN_SIZES)[:-1].tolist()
    h = x
    for l in range(DEPTH):
        proj = h @ w_in[l] + b_in[l]
        dq, dk, dv, iq, ik, iw, sq, sk, sv = jnp.split(proj, offsets, axis=-1)
        dq = apply_rope(dq.reshape(B, S, DSA_HEADS, HEAD_DIM), cos, sin)
        dk = apply_rope(dk.reshape(B, S, 1, HEAD_DIM), cos, sin)[:, :, 0]
        iq = apply_rope(iq.reshape(B, S, IDX_HEADS, IDX_DIM), cos, sin)
        ik = apply_rope(ik.reshape(B, S, 1, IDX_DIM), cos, sin)[:, :, 0]
        o_dsa = dsa_sparse_attention(dq, dk, dv, iq, ik, iw)
        sq = apply_rope(sq.reshape(B, S, SWA_HEADS, HEAD_DIM), cos, sin)
        sk = apply_rope(sk.reshape(B, S, SWA_KV_HEADS, HEAD_DIM), cos, sin)
        sv = sv.reshape(B, S, SWA_KV_HEADS, HEAD_DIM)
        o_swa = swa_sink_attention(sq, sk, sv, swa_sinks[l])
        mix = jnp.concatenate([o_dsa, o_swa], axis=-1) @ w_o[l]
        h = layer_norm(DEEPNORM_ALPHA * h + mix, ln1_g[l], ln1_b[l])
        c = memory_cross_attention(h, mem, wq_mem[l], wk_mem[l], wv_mem[l], wo_mem[l])
        h = layer_norm(DEEPNORM_ALPHA * h + c, ln2_g[l], ln2_b[l])
        m = squared_relu_mlp(h, w_up[l], w_down[l])
        h = layer_norm(DEEPNORM_ALPHA * h + m, ln3_g[l], ln3_b[l])
    return h
```

```cpp
#include <hip/hip_runtime.h>
#include <hip/hip_cooperative_groups.h>
#include <cstdio>
#include <cstdint>
namespace cg = cooperative_groups;

namespace pg8 {
#define PG8_LAS __attribute__((address_space(3)))
typedef unsigned short bf16_t;
typedef short bf16x8 __attribute__((ext_vector_type(8)));
typedef float f32x4 __attribute__((ext_vector_type(4)));
typedef unsigned u32x4 __attribute__((ext_vector_type(4)));
constexpr int BM = 256, BK = 64, HALF = 128, HTB = HALF * BK * 2  , STAGE_BYTES = 8 * HTB, NXCD = 8, WGM = 8;

__host__ __device__ __forceinline__ int lds_byte(int r, int c) { const int st = (r >> 4) * 2 + (c >> 5), rr = r & 15, cc = c & 31, ob = rr * 64 + cc * 2; return st * 1024 + (ob ^ (((ob >> 9) & 1) << 5)); }
__host__ __device__ __forceinline__ void stage_rc(int b, int& R, int& C) { const int st = b / 1024, sb = b % 1024, swz = sb ^ (((sb >> 9) & 1) << 5); R = (st >> 1) * 16 + swz / 64; C = (st & 1) * 32 + (swz % 64) / 2; }
__host__ __device__ __forceinline__ int perm32(int rho) { const int n = rho >> 4, i = rho & 15; return 8 * (i >> 2) + 4 * n + (i & 3); }

struct Unit { int pm, pn; };
struct Gemm { const bf16_t* A; const bf16_t* Bt; int M, N, K; };

struct StaticOrder {
    int nM, nN, nwg, G, c;
    __host__ __device__ void init(int M, int N, int G_, int c_) { nM = M / BM; nN = N / BM; nwg = nM * nN; G = G_; c = c_; }
    __host__ __device__ bool next(int i, Unit& u) const {
        const long L = (long)i * G + c; if (L >= nwg) return false;
        int wgid = (int)L; { const int q = nwg / NXCD, r = nwg % NXCD, xcd = wgid % NXCD, off = wgid / NXCD; wgid = (xcd < r ? xcd * (q + 1) : r * (q + 1) + (xcd - r) * q) + off; }
        const int nig = WGM * nN, gid = wgid / nig, fm = gid * WGM, gsz = (nM - fm) < WGM ? (nM - fm) : WGM;
        u.pm = fm + ((wgid % nig) % gsz); u.pn = (wgid % nig) / gsz; return true;
    }
    __device__ __forceinline__ void a_ready(const Unit&) const {}
    __device__ __forceinline__ void done(const Unit&) const {}
};

struct OneUnit { Unit u; __device__ __forceinline__ bool next(int i, Unit& o) const { if (i != 0) return false; o = u; return true; }
    __device__ __forceinline__ void a_ready(const Unit&) const {} __device__ __forceinline__ void done(const Unit&) const {} };

typedef float f32x2 __attribute__((ext_vector_type(2)));
typedef __bf16 bf16x2_t __attribute__((ext_vector_type(2)));
typedef _Float16 h2_t __attribute__((ext_vector_type(2)));
typedef unsigned u32x2 __attribute__((ext_vector_type(2)));
__device__ __forceinline__ unsigned pkbf(float lo, float hi) { f32x2 v = {lo, hi}; bf16x2_t b = __builtin_convertvector(v, bf16x2_t); return __builtin_bit_cast(unsigned, b); }
__device__ __forceinline__ unsigned pkh(float lo, float hi) { f32x2 v = {lo, hi}; h2_t b = __builtin_convertvector(v, h2_t); return __builtin_bit_cast(unsigned, b); }

__host__ __device__ __forceinline__ int inproj_src(int blk) {
    if (blk < 8) return 64 * blk;
    if (blk == 8) return 512;
    if (blk == 9) return 576;
    if (blk < 18) return 640 + 64 * (blk - 10);
    if (blk == 18) return 1152;
    if (blk < 27) return 1224 + 64 * (blk - 19);
    if (blk < 29) return 1736 + 64 * (blk - 27);
    if (blk < 31) return 1864 + 64 * (blk - 29);
    return 1216;
}

template <int ACT> struct EpiBf16 {
    static constexpr bool PERM = true, AFTER_DRAIN = false;
    bf16_t* O; int ldc; float scale;
    __device__ __forceinline__ void operator()(const f32x4 (&acc)[2][2][4][2], const Unit& u, int wr, int wc, int fr, int fq) const {
        const int row0 = u.pm * BM + wr * 64 + fr; const int col0 = u.pn * BM + wc * 32 + 8 * fq;
#pragma unroll
        for (int ai = 0; ai < 2; ++ai)
#pragma unroll
            for (int m = 0; m < 4; ++m) { bf16_t* rowp = O + (size_t)(row0 + ai * HALF + m * 16) * ldc + col0;
#pragma unroll
                for (int bj = 0; bj < 2; ++bj) { f32x4 v0 = acc[ai][bj][m][0], v1 = acc[ai][bj][m][1];
                    if (ACT == 2) {
#pragma unroll
                        for (int e = 0; e < 4; ++e) { float a = fmaxf(v0[e], 0.f), b = fmaxf(v1[e], 0.f); v0[e] = a * a; v1[e] = b * b; } }
                    v0 = v0 * scale; v1 = v1 * scale; u32x4 w; w.x = pkbf(v0[0], v0[1]); w.y = pkbf(v0[2], v0[3]); w.z = pkbf(v1[0], v1[1]); w.w = pkbf(v1[2], v1[3]);
                    *(u32x4*)(rowp + bj * HALF) = w; } }
    }
};

struct EpiMemKV {
    static constexpr bool PERM = true, AFTER_DRAIN = false;
    bf16_t* KF; bf16_t* O;
    __device__ __forceinline__ void operator()(const f32x4 (&acc)[2][2][4][2], const Unit& u, int wr, int wc, int fr, int fq) const {
        const int row0 = u.pm * BM + wr * 64 + fr; const int col0 = u.pn * BM + wc * 32 + 8 * fq;
#pragma unroll
        for (int ai = 0; ai < 2; ++ai)
#pragma unroll
            for (int m = 0; m < 4; ++m) { const int row = row0 + ai * HALF + m * 16;
#pragma unroll
                for (int bj = 0; bj < 2; ++bj) { const f32x4 v0 = acc[ai][bj][m][0], v1 = acc[ai][bj][m][1];
                    u32x4 w; w.x = pkbf(v0[0], v0[1]); w.y = pkbf(v0[2], v0[3]); w.z = pkbf(v1[0], v1[1]); w.w = pkbf(v1[2], v1[3]);
                    const int col = col0 + bj * HALF;
                    if (col < 1024) { const int b = row >> 8, key = row & 255, head = col >> 8, d = col & 255;
                        const size_t fo = ((size_t)((b * 4 + head) * 128 + (key >> 5) * 16 + (d >> 4)) * 64 + ((d >> 3) & 1) * 32 + (key & 31)) * 8;
                        *(u32x4*)(KF + fo) = w; }
                    else *(u32x4*)(O + (size_t)row * 2048 + col) = w; } }
    }
};

struct EpiInProj {
    static constexpr bool PERM = false, AFTER_DRAIN = false;
    const float* bias; const float* cosT; const float* sinT;
    bf16_t *dq, *dk, *dv, *sq, *sk, *sv; _Float16 *iq, *ik; float* iw;
    __device__ __forceinline__ void operator()(const f32x4 (&acc)[2][2][4][2], const Unit& u, int wr, int wc, int fr, int fq) const {
        const int g1 = wc & 1;
        const int dloc = 16 * g1 + 4 * fq;
#pragma unroll
        for (int bj = 0; bj < 2; ++bj) {
            const int blk = u.pn * 4 + bj * 2 + (wc >> 1);
            const int src = inproj_src(blk);
            const f32x4 b1 = *(const f32x4*)(bias + src + dloc), b2 = *(const f32x4*)(bias + src + 32 + dloc);
            unsigned short* dst; int ld, c0; bool rope = true, half16 = false;
            if (blk < 8) { dst = dq; ld = 512; c0 = blk * 64; }
            else if (blk == 8) { dst = dk; ld = 64; c0 = 0; }
            else if (blk == 9) { dst = dv; ld = 64; c0 = 0; rope = false; }
            else if (blk < 18) { dst = (unsigned short*)iq; ld = 512; c0 = (blk - 10) * 64; half16 = true; }
            else if (blk == 18) { dst = (unsigned short*)ik; ld = 64; c0 = 0; half16 = true; }
            else if (blk < 27) { dst = sq; ld = 512; c0 = (blk - 19) * 64; }
            else if (blk < 29) { dst = sk; ld = 128; c0 = (blk - 27) * 64; }
            else if (blk < 31) { dst = sv; ld = 128; c0 = (blk - 29) * 64; rope = false; }
            else { dst = nullptr; ld = 0; c0 = 0; rope = false; }
#pragma unroll
            for (int ai = 0; ai < 2; ++ai)
#pragma unroll
                for (int m = 0; m < 4; ++m) {
                    const int row = u.pm * BM + ai * HALF + wr * 64 + m * 16 + fr;
                    f32x4 x1 = acc[ai][bj][m][0] + b1, x2 = acc[ai][bj][m][1] + b2;
                    if (blk == 31) { if (g1 == 0 && fq < 2) *(f32x4*)(iw + (size_t)row * 8 + 4 * fq) = x1; continue; }
                    f32x4 o1 = x1, o2 = x2;
                    if (rope) { const f32x4 c = *(const f32x4*)(cosT + (size_t)row * 32 + dloc), s = *(const f32x4*)(sinT + (size_t)row * 32 + dloc);
                        o1 = x1 * c - x2 * s; o2 = x2 * c + x1 * s; }
                    u32x2 w1, w2;
                    if (half16) { w1.x = pkh(o1[0], o1[1]); w1.y = pkh(o1[2], o1[3]); w2.x = pkh(o2[0], o2[1]); w2.y = pkh(o2[2], o2[3]); }
                    else { w1.x = pkbf(o1[0], o1[1]); w1.y = pkbf(o1[2], o1[3]); w2.x = pkbf(o2[0], o2[1]); w2.y = pkbf(o2[2], o2[3]); }
                    if (blk == 18) {
                        const int t = row & 8191; const size_t fo = (size_t)(row >> 13) * (8192 * 64) + ((size_t)((t >> 5) * 4 + (dloc >> 4)) * 64 + ((dloc >> 3) & 1) * 32 + (t & 31)) * 8 + (dloc & 7);
                        *(u32x2*)(dst + fo) = w1; *(u32x2*)(dst + fo + 2 * 512) = w2; continue; }
                    unsigned short* p = dst + (size_t)row * ld + c0 + dloc;
                    *(u32x2*)p = w1; *(u32x2*)(p + 32) = w2;
                }
        }
    }
};

__device__ __forceinline__ f32x4 ld4(const float* p) { return *(const f32x4*)p; }
__device__ __forceinline__ f32x4 ld4(const bf16_t* p) { const u32x2 w = *(const u32x2*)p; return (f32x4){__uint_as_float(w.x << 16), __uint_as_float(w.x & 0xffff0000u), __uint_as_float(w.y << 16), __uint_as_float(w.y & 0xffff0000u)}; }
__device__ __forceinline__ void st4(float* p, f32x4 v) { *(f32x4*)p = v; }
__device__ __forceinline__ void st4(bf16_t* p, f32x4 v) { u32x2 w; w.x = pkbf(v[0], v[1]); w.y = pkbf(v[2], v[3]); *(u32x2*)p = w; }
__device__ __forceinline__ void ld8(const float* p, f32x4& a, f32x4& b) { a = *(const f32x4*)p; b = *(const f32x4*)(p + 4); }
__device__ __forceinline__ void ld8(const bf16_t* p, f32x4& a, f32x4& b) { const u32x4 w = *(const u32x4*)p;
    a = (f32x4){__uint_as_float(w.x << 16), __uint_as_float(w.x & 0xffff0000u), __uint_as_float(w.y << 16), __uint_as_float(w.y & 0xffff0000u)};
    b = (f32x4){__uint_as_float(w.z << 16), __uint_as_float(w.z & 0xffff0000u), __uint_as_float(w.w << 16), __uint_as_float(w.w & 0xffff0000u)}; }
__device__ __forceinline__ void st8(float* p, f32x4 a, f32x4 b) { *(f32x4*)p = a; *(f32x4*)(p + 4) = b; }
__device__ __forceinline__ void st8(bf16_t* p, f32x4 a, f32x4 b) { u32x4 w; w.x = pkbf(a[0], a[1]); w.y = pkbf(a[2], a[3]); w.z = pkbf(b[0], b[1]); w.w = pkbf(b[2], b[3]); *(u32x4*)p = w; }
template <bool LN, class TIN, class TOUT> struct EpiRes {
    static constexpr bool PERM = true, AFTER_DRAIN = false;
    const TIN* prev; TOUT* out; const f32x2* stats; const float* g; const float* b; float alpha;
    __device__ __forceinline__ void operator()(const f32x4 (&acc)[2][2][4][2], const Unit& u, int wr, int wc, int fr, int fq) const {
        const int col0 = u.pn * BM + wc * 32 + 8 * fq;
#pragma unroll
        for (int bj = 0; bj < 2; ++bj) {
            const int col = col0 + bj * HALF;
            f32x4 g0 = {1.f, 1.f, 1.f, 1.f}, g1 = g0, b0 = {0.f, 0.f, 0.f, 0.f}, b1 = b0;
            if (LN) { g0 = *(const f32x4*)(g + col); g1 = *(const f32x4*)(g + col + 4); b0 = *(const f32x4*)(b + col); b1 = *(const f32x4*)(b + col + 4); }
#pragma unroll
            for (int ai = 0; ai < 2; ++ai)
#pragma unroll
                for (int m = 0; m < 4; ++m) {
                    const int row = u.pm * BM + ai * HALF + wr * 64 + m * 16 + fr;
                    f32x2 st = {0.f, 1.f}; if (LN) st = stats[row];
                    const size_t off = (size_t)row * 1024 + col;
                    f32x4 r0, r1; ld8(prev + off, r0, r1);
                    if (LN) { r0 = (r0 - st.x) * st.y * g0 + b0; r1 = (r1 - st.x) * st.y * g1 + b1; }
                    st8(out + off, r0 * alpha + acc[ai][bj][m][0], r1 * alpha + acc[ai][bj][m][1]);
                }
        }
    }
};

template <class Epi, class Sched, bool ALIGN_EPI = false, bool SP2 = false>
__device__ __forceinline__ void gemm_phase(PG8_LAS unsigned char* lds, const Gemm g, const Sched& S, const Epi& E) {
    int tid_l = threadIdx.x; asm volatile("" : "+v"(tid_l));
    const int tid = tid_l, wid = __builtin_amdgcn_readfirstlane(tid >> 6), lane = tid & 63, wr = wid >> 2, wc = wid & 3, fr = lane & 15, fq = lane >> 4;
    const int K = g.K, nt = K / BK;
    unsigned voffA[2], voffB[2];
#pragma unroll
    for (int i = 0; i < 2; ++i) { int R, C; stage_rc(tid * 16 + i * 8192, R, C); const int Rb = Epi::PERM ? ((R & ~31) + perm32(R & 31)) : R;
        voffA[i] = (unsigned)(R * K + C) * 2u; voffB[i] = (unsigned)(Rb * K + C) * 2u; }
    const size_t kstep = (size_t)(BK * 2);
    const size_t hstep = (size_t)HALF * K * 2;
    const size_t tstep = 2 * hstep;
    const unsigned ldsw = (unsigned)wid * 1024u;
    const int aoff = lds_byte(wr * 64 + fr, fq * 8), boff = lds_byte(wc * 32 + fr, fq * 8);
#define PG8_SA(b, h) (((b) * 2 + (h)) * HTB)
#define PG8_SB(b, h) ((4 + (b) * 2 + (h)) * HTB)
#define PG8_STAGE(bufoff, gbase, voff) do { _Pragma("unroll") for (int _i = 0; _i < 2; ++_i) \
        __builtin_amdgcn_global_load_lds((const unsigned*)((const char*)(gbase) + (voff)[_i]), (PG8_LAS unsigned*)(lds + (bufoff) + ldsw + _i * 8192), 16, 0, 0); } while (0)
#define PG8_LDA(dst, b, h) do { _Pragma("unroll") for (int m = 0; m < 4; ++m) _Pragma("unroll") for (int k = 0; k < 2; ++k) dst[m][k] = *(const PG8_LAS bf16x8*)(lds + PG8_SA(b, h) + aoff + m * 2048 + k * 1024); } while (0)
#define PG8_LDB(dst, b, h) do { _Pragma("unroll") for (int n = 0; n < 2; ++n) _Pragma("unroll") for (int k = 0; k < 2; ++k) dst[n][k] = *(const PG8_LAS bf16x8*)(lds + PG8_SB(b, h) + boff + n * 2048 + k * 1024); } while (0)
#define PG8_MMA(ai, bj, At, Bt) do { __builtin_amdgcn_s_setprio(1); _Pragma("unroll") for (int m = 0; m < 4; ++m) _Pragma("unroll") for (int n = 0; n < 2; ++n) _Pragma("unroll") for (int k = 0; k < 2; ++k) \
        acc[ai][bj][m][n] = __builtin_amdgcn_mfma_f32_16x16x32_bf16(Bt[n][k], At[m][k], acc[ai][bj][m][n], 0, 0, 0); __builtin_amdgcn_s_setprio(0); } while (0)
#define PG8_WAIT_V(n) asm volatile("s_waitcnt vmcnt(" #n ")" ::: "memory")
#define PG8_WAIT_L(n) asm volatile("s_waitcnt lgkmcnt(" #n ")" ::: "memory")
#define PG8_BAR __builtin_amdgcn_s_barrier()
#define PG8_SCHED __builtin_amdgcn_sched_barrier(0)
    Unit cur, nxt; int ui = 0;
    if (!S.next(0, cur)) return;
    f32x4 acc[2][2][4][2];
#pragma unroll
    for (int a = 0; a < 2; ++a)
#pragma unroll
        for (int b = 0; b < 2; ++b)
#pragma unroll
            for (int m = 0; m < 4; ++m)
#pragma unroll
                for (int n = 0; n < 2; ++n) acc[a][b][m][n] = (f32x4){0.f, 0.f, 0.f, 0.f};
    bf16x8 At[4][2], B0[2][2], B1[2][2];
    const char* cA = (const char*)g.A + (size_t)cur.pm * tstep; const char* cB = (const char*)g.Bt + (size_t)cur.pn * tstep;
    S.a_ready(cur);
    if constexpr (SP2) {
        PG8_STAGE(PG8_SB(0, 0), cB, voffB); PG8_STAGE(PG8_SB(0, 1), cB + hstep, voffB); PG8_STAGE(PG8_SA(0, 0), cA, voffA); PG8_STAGE(PG8_SA(0, 1), cA + hstep, voffA);
        if (wr == 1) PG8_BAR;
        PG8_WAIT_V(2); PG8_BAR;
        PG8_STAGE(PG8_SB(1, 0), cB + kstep, voffB); PG8_STAGE(PG8_SA(1, 0), cA + kstep, voffA); PG8_STAGE(PG8_SB(1, 1), cB + hstep + kstep, voffB);
        PG8_WAIT_V(6); PG8_BAR;
    } else {
        PG8_STAGE(PG8_SB(0, 0), cB, voffB); PG8_STAGE(PG8_SA(0, 0), cA, voffA); PG8_STAGE(PG8_SB(0, 1), cB + hstep, voffB); PG8_STAGE(PG8_SA(0, 1), cA + hstep, voffA);
        if (wr == 1) PG8_BAR;
        PG8_WAIT_V(4); PG8_BAR;
        PG8_STAGE(PG8_SB(1, 0), cB + kstep, voffB); PG8_STAGE(PG8_SA(1, 0), cA + kstep, voffA); PG8_STAGE(PG8_SB(1, 1), cB + hstep + kstep, voffB);
        PG8_WAIT_V(6); PG8_BAR;
    }
    for (;;) {
        const bool has_next = S.next(ui + 1, nxt);
        const char* nA = has_next ? (const char*)g.A + (size_t)nxt.pm * tstep : cA; const char* nB = has_next ? (const char*)g.Bt + (size_t)nxt.pn * tstep : cB;
        for (int t = 0; t < nt; t += 2) {
            const bool last = (t == nt - 2);
            const char* a1 = cA + (size_t)(t + 1) * kstep;
            const char* a2 = last ? nA : cA + (size_t)(t + 2) * kstep; const char* b2 = last ? nB : cB + (size_t)(t + 2) * kstep;
            const char* a3 = a2 + kstep; const char* b3 = b2 + kstep;
            if (last && has_next) S.a_ready(nxt);
            if constexpr (SP2) {
            PG8_LDB(B0, 0, 0); PG8_LDB(B1, 0, 1); PG8_SCHED; PG8_LDA(At, 0, 0); PG8_STAGE(PG8_SA(1, 1), a1 + hstep, voffA);
            PG8_WAIT_V(8); PG8_WAIT_L(0); PG8_BAR; PG8_MMA(0, 0, At, B0); PG8_MMA(0, 1, At, B1); PG8_BAR; PG8_SCHED;
            PG8_LDA(At, 0, 1); PG8_STAGE(PG8_SB(0, 0), b2, voffB); PG8_STAGE(PG8_SB(0, 1), b2 + hstep, voffB); PG8_STAGE(PG8_SA(0, 0), a2, voffA);
            PG8_WAIT_V(8); PG8_WAIT_L(0); PG8_BAR; PG8_MMA(1, 0, At, B0); PG8_MMA(1, 1, At, B1); PG8_BAR; PG8_SCHED;
            PG8_LDB(B0, 1, 0); PG8_LDB(B1, 1, 1); PG8_SCHED; PG8_LDA(At, 1, 0); PG8_STAGE(PG8_SA(0, 1), a2 + hstep, voffA);
            PG8_WAIT_V(8); PG8_WAIT_L(0); PG8_BAR; PG8_MMA(0, 0, At, B0); PG8_MMA(0, 1, At, B1); PG8_BAR; PG8_SCHED;
            PG8_LDA(At, 1, 1); PG8_STAGE(PG8_SB(1, 0), b3, voffB); PG8_STAGE(PG8_SB(1, 1), b3 + hstep, voffB); PG8_STAGE(PG8_SA(1, 0), a3, voffA);
            PG8_WAIT_V(8); PG8_WAIT_L(0); PG8_BAR; PG8_MMA(1, 0, At, B0); PG8_MMA(1, 1, At, B1); PG8_BAR; PG8_SCHED;
            } else {
            PG8_LDB(B0, 0, 0); PG8_SCHED; PG8_LDA(At, 0, 0); PG8_STAGE(PG8_SA(1, 1), a1 + hstep, voffA);
            PG8_WAIT_L(8); PG8_BAR; PG8_WAIT_L(0); PG8_MMA(0, 0, At, B0); PG8_BAR; PG8_SCHED;
            PG8_LDB(B1, 0, 1); PG8_STAGE(PG8_SB(0, 0), b2, voffB);
            PG8_BAR; PG8_WAIT_L(0); PG8_MMA(0, 1, At, B1); PG8_BAR;
            PG8_LDA(At, 0, 1); PG8_STAGE(PG8_SA(0, 0), a2, voffA);
            PG8_BAR; PG8_WAIT_L(0); PG8_MMA(1, 0, At, B0); PG8_BAR; PG8_SCHED;
            PG8_STAGE(PG8_SB(0, 1), b2 + hstep, voffB);
            PG8_WAIT_V(6); PG8_BAR; PG8_MMA(1, 1, At, B1); PG8_BAR;
            PG8_LDB(B0, 1, 0); PG8_SCHED; PG8_LDA(At, 1, 0); PG8_STAGE(PG8_SA(0, 1), a2 + hstep, voffA);
            PG8_WAIT_L(8); PG8_BAR; PG8_WAIT_L(0); PG8_MMA(0, 0, At, B0); PG8_BAR; PG8_SCHED;
            PG8_LDB(B1, 1, 1); PG8_STAGE(PG8_SB(1, 0), b3, voffB);
            PG8_BAR; PG8_WAIT_L(0); PG8_MMA(0, 1, At, B1); PG8_BAR;
            PG8_LDA(At, 1, 1); PG8_STAGE(PG8_SA(1, 0), a3, voffA);
            PG8_BAR; PG8_WAIT_L(0); PG8_MMA(1, 0, At, B0); PG8_BAR; PG8_SCHED;
            PG8_STAGE(PG8_SB(1, 1), b3 + hstep, voffB);
            PG8_WAIT_V(6); PG8_BAR; PG8_MMA(1, 1, At, B1); PG8_BAR;
            }
        }
        if constexpr (ALIGN_EPI) { if (wr == 0) PG8_BAR; }
        if constexpr (!Epi::AFTER_DRAIN) { E(acc, cur, wr, wc, fr, fq); S.done(cur); }
        if (!has_next) break;
#pragma unroll
        for (int a = 0; a < 2; ++a)
#pragma unroll
            for (int b = 0; b < 2; ++b)
#pragma unroll
                for (int m = 0; m < 4; ++m)
#pragma unroll
                    for (int n = 0; n < 2; ++n) acc[a][b][m][n] = (f32x4){0.f, 0.f, 0.f, 0.f};
        cur = nxt; cA = nA; cB = nB; ++ui;
        if constexpr (ALIGN_EPI) { if (wr == 1) PG8_BAR; }
    }
    PG8_WAIT_V(0);
    if constexpr (!ALIGN_EPI) { if (wr == 0) PG8_BAR; }
    PG8_BAR;
    if constexpr (Epi::AFTER_DRAIN) { E.fused(acc, cur, wr, wc, fr, fq, lds, wid, lane); S.done(cur); }
#undef PG8_SA
#undef PG8_SB
#undef PG8_STAGE
#undef PG8_LDA
#undef PG8_LDB
#undef PG8_MMA
#undef PG8_WAIT_V
#undef PG8_WAIT_L
#undef PG8_BAR
#undef PG8_SCHED
}
}
#define LAS __attribute__((address_space(3)))
typedef unsigned short bf16;
typedef short bf16x8 __attribute__((ext_vector_type(8)));
typedef _Float16 f16x8 __attribute__((ext_vector_type(8)));
typedef float f32x4 __attribute__((ext_vector_type(4)));
typedef float f32x16 __attribute__((ext_vector_type(16)));
typedef float f32x2 __attribute__((ext_vector_type(2)));
typedef unsigned u32x4 __attribute__((ext_vector_type(4)));
typedef unsigned u32x2 __attribute__((ext_vector_type(2)));
typedef short v4i16_t __attribute__((ext_vector_type(4)));
using pg8::pkbf;

constexpr int NB = 4, SEQ = 8192, DM = 1024, MTOK = NB * SEQ, NPROJ = 2048, FF = 4096, MEMT = 256, MROWS = NB * MEMT;
constexpr float LN_EPS = 1e-5f;
constexpr float ALPHA = 1.189207115002721f;
constexpr float LOG2E = 1.4426950408889634f;
constexpr int NWAVES = 8, NTHR = 512;
constexpr int LDS_BYTES = 163840;
constexpr int MISC_OFF = 163328;

constexpr size_t MiB = 1u << 20;
constexpr size_t WS_WIN = 1 * MiB, WS_WO = 5 * MiB, WS_WQ = 7 * MiB, WS_WKV = 9 * MiB, WS_WOM = 13 * MiB, WS_WUP = 15 * MiB, WS_WDN = 23 * MiB;
constexpr size_t WS_MEMB = 31 * MiB, WS_MEMKV = 33 * MiB, WS_COS = 37 * MiB, WS_SIN = 41 * MiB, WS_ST1 = 45 * MiB, WS_ST2 = 46 * MiB;
constexpr size_t WS_MEMKF = 496 * MiB;
constexpr size_t WS_RA = 48 * MiB;
constexpr size_t WS_RB = 112 * MiB;
constexpr size_t WS_DQ = WS_RB, WS_SQ = WS_RB + 32 * MiB, WS_IQ = WS_RB + 64 * MiB, WS_DK = WS_RB + 96 * MiB, WS_DV = WS_RB + 100 * MiB, WS_IK = WS_RB + 104 * MiB,
                 WS_SK = WS_RB + 108 * MiB, WS_SV = WS_RB + 116 * MiB, WS_IW = WS_RB + 124 * MiB;
constexpr size_t WS_RC = 240 * MiB;
constexpr size_t WS_RD = 368 * MiB;
constexpr size_t WS_RE = 432 * MiB;
constexpr size_t WS_END = 498 * MiB;

__device__ __forceinline__ int crow(int reg, int hi) { return (reg & 3) + 8 * (reg >> 2) + 4 * hi; }
__device__ __forceinline__ float wave_sum(float v) {
#pragma unroll
    for (int o = 1; o < 64; o <<= 1) v += __shfl_xor(v, o);
    return v;
}
__device__ __forceinline__ v4i16_t trrd(LAS unsigned char* p) { return __builtin_amdgcn_ds_read_tr16_b64_v4i16((LAS v4i16_t*)p); }
#define MFMA32BF(a, b, c) __builtin_amdgcn_mfma_f32_32x32x16_bf16((a), (b), (c), 0, 0, 0)
#define MFMA16BF(a, b, c) __builtin_amdgcn_mfma_f32_16x16x32_bf16((a), (b), (c), 0, 0, 0)
#define MFMA32H(a, b, c) __builtin_amdgcn_mfma_f32_32x32x16_f16((a), (b), (c), 0, 0, 0)

struct Params {
    const float* x; const float* mem; const int* pos; const float* w_in; const float* b_in; const float* sinks; const float* w_o;
    const float* ln1g; const float* ln1b; const float* wq; const float* wk; const float* wv; const float* wom; const float* ln2g; const float* ln2b;
    const float* wup; const float* wdn; const float* ln3g; const float* ln3b;
    float* out; unsigned char* ws;
};

__device__ __forceinline__ void transpose_item(const float* W, int K, int N, bf16* WT, int row_off, int nblk, int mode, LAS float* scr, int item, int lane) {
    const int kb = item / nblk, nb = item % nblk, k0 = 64 * kb, n0 = 32 * nb;
    const int nl = lane & 31;
    int src = n0 + nl;
    if (mode == 1) { const int blk = nb >> 1, g1 = nb & 1, n = nl >> 4, i = nl & 15, d = 32 * n + 16 * g1 + i; src = pg8::inproj_src(blk) + d; if (blk == 31 && d >= 8) src = -1; }
#pragma unroll 8
    for (int i = 0; i < 32; ++i) { const int kk = 2 * i + (lane >> 5); scr[kk * 33 + nl] = (src >= 0) ? W[(size_t)(k0 + kk) * N + src] : 0.f; }
    asm volatile("s_waitcnt lgkmcnt(0)" ::: "memory");
    const int c = lane & 7;
#pragma unroll
    for (int j = 0; j < 4; ++j) { const int n = (lane >> 3) + 8 * j; const LAS float* s = scr + (8 * c) * 33 + n;
        u32x4 o; o.x = pkbf(s[0 * 33], s[1 * 33]); o.y = pkbf(s[2 * 33], s[3 * 33]); o.z = pkbf(s[4 * 33], s[5 * 33]); o.w = pkbf(s[6 * 33], s[7 * 33]);
        *(u32x4*)(WT + (size_t)(row_off + n0 + n) * K + k0 + 8 * c) = o; }
    asm volatile("s_waitcnt lgkmcnt(0)" ::: "memory");
}

__device__ __forceinline__ void p0_prologue(const Params& P, LAS unsigned char* lds, int bid, int G, int tid, int wid, int lane) {
    asm volatile("" : "+v"(lane), "+v"(tid));
    unsigned char* ws = P.ws;
    LAS float* scr = (LAS float*)(lds + wid * 16384);
    const int gw = bid * NWAVES + wid, NGW = G * NWAVES;
    constexpr int I_IN = 16 * 64, I_SQ = 16 * 32, I_UP = 16 * 128, I_DN = 64 * 32;
    constexpr int NITEMS = I_IN + 5 * I_SQ + I_UP + I_DN;
    for (int it = gw; it < NITEMS; it += NGW) {
        int r = it;
        if (r < I_IN) { transpose_item(P.w_in, DM, 1992, (bf16*)(ws + WS_WIN), 0, 64, 1, scr, r, lane); continue; } r -= I_IN;
        if (r < I_SQ) { transpose_item(P.w_o, DM, DM, (bf16*)(ws + WS_WO), 0, 32, 0, scr, r, lane); continue; } r -= I_SQ;
        if (r < I_SQ) { transpose_item(P.wq, DM, DM, (bf16*)(ws + WS_WQ), 0, 32, 0, scr, r, lane); continue; } r -= I_SQ;
        if (r < I_SQ) { transpose_item(P.wk, DM, DM, (bf16*)(ws + WS_WKV), 0, 32, 0, scr, r, lane); continue; } r -= I_SQ;
        if (r < I_SQ) { transpose_item(P.wv, DM, DM, (bf16*)(ws + WS_WKV), 1024, 32, 0, scr, r, lane); continue; } r -= I_SQ;
        if (r < I_SQ) { transpose_item(P.wom, DM, DM, (bf16*)(ws + WS_WOM), 0, 32, 0, scr, r, lane); continue; } r -= I_SQ;
        if (r < I_UP) { transpose_item(P.wup, DM, FF, (bf16*)(ws + WS_WUP), 0, 128, 0, scr, r, lane); continue; } r -= I_UP;
        transpose_item(P.wdn, FF, DM, (bf16*)(ws + WS_WDN), 0, 32, 0, scr, r, lane);
    }
    const int gt = bid * NTHR + tid, NGT = G * NTHR;
    { bf16* xb = (bf16*)(ws + WS_RA);
      for (int i = gw; i < MTOK * DM / 512; i += NGW) { const size_t base = (size_t)i * 512 + 4 * lane;
          const f32x4 a = *(const f32x4*)(P.x + base), b = *(const f32x4*)(P.x + base + 256);
          u32x2 oa, ob; oa.x = pkbf(a[0], a[1]); oa.y = pkbf(a[2], a[3]); ob.x = pkbf(b[0], b[1]); ob.y = pkbf(b[2], b[3]);
          *(u32x2*)(xb + base) = oa; *(u32x2*)(xb + base + 256) = ob; }
      bf16* mb = (bf16*)(ws + WS_MEMB);
      for (int i = gw; i < MROWS * DM / 512; i += NGW) { const size_t base = (size_t)i * 512 + 4 * lane;
          const f32x4 a = *(const f32x4*)(P.mem + base), b = *(const f32x4*)(P.mem + base + 256);
          u32x2 oa, ob; oa.x = pkbf(a[0], a[1]); oa.y = pkbf(a[2], a[3]); ob.x = pkbf(b[0], b[1]); ob.y = pkbf(b[2], b[3]);
          *(u32x2*)(mb + base) = oa; *(u32x2*)(mb + base + 256) = ob; } }
    { float* cT = (float*)(ws + WS_COS); float* sT = (float*)(ws + WS_SIN);
      for (int i = gt; i < MTOK * 32; i += NGT) { const int tok = i >> 5, k = i & 31;
          const double inv = exp2(-(double)k * (13.287712379549449 / 32.0));
          const double ang = (double)P.pos[tok] * inv;
          const double r = ang - 6.283185307179586476925 * rint(ang * 0.15915494309189533577);
          const float rf = (float)r; cT[i] = cosf(rf); sT[i] = sinf(rf); } }
}

template <class TIN> __device__ __forceinline__ void ln_pass(const TIN* y, const float* g, const float* b, bf16* hb, f32x2* stats, float* outf, int gw, int NGW, int lane) {
    asm volatile("" : "+v"(lane));
    f32x4 gv[4], bv[4];
#pragma unroll
    for (int j = 0; j < 4; ++j) { gv[j] = *(const f32x4*)(g + 4 * lane + 256 * j); bv[j] = *(const f32x4*)(b + 4 * lane + 256 * j); }
#pragma unroll 2
    for (int m = gw; m < MTOK; m += NGW) {
        f32x4 v[4]; float s = 0.f;
#pragma unroll
        for (int j = 0; j < 4; ++j) { v[j] = pg8::ld4(y + (size_t)m * DM + 4 * lane + 256 * j); s += (v[j][0] + v[j][1]) + (v[j][2] + v[j][3]); }
        const float mean = wave_sum(s) * (1.f / DM); float s2 = 0.f;
#pragma unroll
        for (int j = 0; j < 4; ++j) { v[j] = v[j] - mean; s2 += (v[j][0] * v[j][0] + v[j][1] * v[j][1]) + (v[j][2] * v[j][2] + v[j][3] * v[j][3]); }
        const float rstd = 1.f / sqrtf(wave_sum(s2) * (1.f / DM) + LN_EPS);
        if (stats && lane == 0) stats[m] = (f32x2){mean, rstd};
#pragma unroll
        for (int j = 0; j < 4; ++j) { const f32x4 o = v[j] * rstd * gv[j] + bv[j];
            if (hb) { u32x2 w; w.x = pkbf(o[0], o[1]); w.y = pkbf(o[2], o[3]); *((u32x2*)(hb + (size_t)m * DM) + lane + 64 * j) = w; }
            if (outf) *((f32x4*)(outf + (size_t)m * DM) + lane + 64 * j) = o; }
    }
}

__device__ __forceinline__ unsigned okey(float f) { unsigned u = __float_as_uint(f); if ((u << 1) == 0u) u = 0u; return u ^ (((unsigned)((int)u >> 31)) | 0x80000000u); }
constexpr int DSA_C = 808;
constexpr int DSA_WREG = 20416;
constexpr int DSA_QB = 4848, DSA_IOFF = 3232;
constexpr int DSA_NE = 13;
#ifndef DSA_RD
#define DSA_RD 3
#endif

#define DPPI(v, ctrl) ((unsigned)__builtin_amdgcn_update_dpp((int)(v), (int)(v), (ctrl), 0xF, 0xF, false))
__device__ __forceinline__ unsigned wave_and(unsigned v) {
    v &= DPPI(v, 0xB1); v &= DPPI(v, 0x4E); v &= DPPI(v, 0x141); v &= DPPI(v, 0x140);
    return (unsigned)__builtin_amdgcn_readlane((int)v, 0) & (unsigned)__builtin_amdgcn_readlane((int)v, 16) & (unsigned)__builtin_amdgcn_readlane((int)v, 32) & (unsigned)__builtin_amdgcn_readlane((int)v, 48); }
__device__ __forceinline__ unsigned wave_or(unsigned v) {
    v |= DPPI(v, 0xB1); v |= DPPI(v, 0x4E); v |= DPPI(v, 0x141); v |= DPPI(v, 0x140);
    return (unsigned)__builtin_amdgcn_readlane((int)v, 0) | (unsigned)__builtin_amdgcn_readlane((int)v, 16) | (unsigned)__builtin_amdgcn_readlane((int)v, 32) | (unsigned)__builtin_amdgcn_readlane((int)v, 48); }

constexpr unsigned DSA_KEEP = 384u;
template <bool EXACT>
__device__ __forceinline__ unsigned dsa_compact(LAS unsigned char* qreg, LAS unsigned* hist, int cnt, int lane, int& newcnt) {
    __builtin_amdgcn_s_setprio(2);
    LAS unsigned* kb = (LAS unsigned*)qreg; LAS unsigned short* ib = (LAS unsigned short*)(qreg + DSA_IOFF);
    unsigned ek[DSA_NE]; unsigned short ei[DSA_NE];
#pragma unroll
    for (int i = 0; i < DSA_NE; ++i) { const int e = i * 64 + lane; const unsigned kv = kb[e]; ei[i] = ib[e]; ek[i] = (e < cnt) ? kv : 0u; }
    unsigned av = 0xFFFFFFFFu, ov = 0u;
#pragma unroll
    for (int i = 0; i < DSA_NE; ++i) { av &= (i * 64 + lane < cnt) ? ek[i] : 0xFFFFFFFFu; ov |= ek[i]; }
    av = wave_and(av); ov = wave_or(ov);
    const unsigned diff = av ^ ov;
    int sprev = diff ? (32 - __builtin_clz(diff)) : 0;
    unsigned prefix = (sprev < 32) ? ((ov >> sprev) << sprev) : 0u;
    unsigned krem = 256u; unsigned kept = (unsigned)cnt;
#pragma unroll 1
    while (sprev > 0 && (EXACT || kept > DSA_KEEP)) {
        const int s = sprev > 8 ? sprev - 8 : 0;
        const unsigned mask = (sprev < 32) ? (0xFFFFFFFFu << sprev) : 0u;
        *(LAS u32x4*)(hist + 4 * lane) = (u32x4){0u, 0u, 0u, 0u};
#pragma unroll
        for (int i = 0; i < DSA_NE; ++i) { if ((i * 64 + lane < cnt) && ((ek[i] & mask) == prefix)) __hip_atomic_fetch_add(hist + ((ek[i] >> s) & 255u), 1u, __ATOMIC_RELAXED, __HIP_MEMORY_SCOPE_WORKGROUP); }
        asm volatile("s_waitcnt lgkmcnt(0)" ::: "memory");
        const u32x4 hv = *(const LAS u32x4*)(hist + 4 * lane);
        const unsigned tot = hv.x + hv.y + hv.z + hv.w;
        unsigned suf = tot;
        suf += (unsigned)__builtin_amdgcn_update_dpp(0, (int)suf, 0x101, 0xF, 0xF, true);
        suf += (unsigned)__builtin_amdgcn_update_dpp(0, (int)suf, 0x102, 0xF, 0xF, true);
        suf += (unsigned)__builtin_amdgcn_update_dpp(0, (int)suf, 0x104, 0xF, 0xF, true);
        suf += (unsigned)__builtin_amdgcn_update_dpp(0, (int)suf, 0x108, 0xF, 0xF, true);
        { const unsigned r1 = (unsigned)__builtin_amdgcn_readlane((int)suf, 16), r2 = (unsigned)__builtin_amdgcn_readlane((int)suf, 32), r3 = (unsigned)__builtin_amdgcn_readlane((int)suf, 48);
          const int row = lane >> 4; suf += row == 0 ? (r1 + r2 + r3) : row == 1 ? (r2 + r3) : row == 2 ? r3 : 0u; }
        const unsigned c3 = suf - tot, c2 = c3 + hv.w, c1 = c2 + hv.z, c0 = c1 + hv.y;
        int sel = -1; unsigned cg_ = 0u, hc_ = 0u;
        if (c3 < krem && krem <= c3 + hv.w) { sel = 3; cg_ = c3; hc_ = hv.w; }
        else if (c2 < krem && krem <= c2 + hv.z) { sel = 2; cg_ = c2; hc_ = hv.z; }
        else if (c1 < krem && krem <= c1 + hv.y) { sel = 1; cg_ = c1; hc_ = hv.y; }
        else if (c0 < krem && krem <= c0 + hv.x) { sel = 0; cg_ = c0; hc_ = hv.x; }
        const unsigned long long bal = __ballot(sel >= 0);
        const int srcl = bal ? (int)__builtin_ctzll(bal) : 0;
        const unsigned dbin = (unsigned)__builtin_amdgcn_readlane(4 * lane + (sel >= 0 ? sel : 0), srcl);
        const unsigned cgt = (unsigned)__builtin_amdgcn_readlane((int)cg_, srcl);
        const unsigned hcn = (unsigned)__builtin_amdgcn_readlane((int)hc_, srcl);
        prefix |= dbin << s; krem -= cgt; sprev = s;
        kept = 256u - krem + hcn;
    }
    unsigned T = prefix;
    if (!EXACT && sprev > 0) { T = prefix - 1u; krem = 0u; newcnt = (int)kept; } else { newcnt = 256; }
    unsigned run = 0u, eqrun = 0u;
    LAS unsigned* dK = hist + lane; LAS unsigned short* dI = (LAS unsigned short*)(hist + 128) + lane;
#pragma unroll
    for (int i = 0; i < DSA_NE; ++i) {
        const unsigned key = ek[i];
        bool take = key > T;
        if (EXACT) { const bool eq = key == T; const unsigned long long eqm = __ballot(eq);
            const unsigned eqrank = eqrun + __builtin_amdgcn_mbcnt_hi((unsigned)(eqm >> 32), __builtin_amdgcn_mbcnt_lo((unsigned)eqm, 0u));
            take = take || (eq && eqrank < krem); eqrun += (unsigned)__builtin_popcountll(eqm); }
        const unsigned long long tm = __ballot(take);
        const unsigned pos = run + __builtin_amdgcn_mbcnt_hi((unsigned)(tm >> 32), __builtin_amdgcn_mbcnt_lo((unsigned)tm, 0u));
        LAS unsigned* pk = take ? (kb + pos) : dK; LAS unsigned short* pi = take ? (ib + pos) : dI;
        *pk = key; *pi = ei[i];
        run += (unsigned)__builtin_popcountll(tm);
    }
    asm volatile("s_waitcnt lgkmcnt(0)" ::: "memory");
    __builtin_amdgcn_s_setprio(0);
    return T;
}

__device__ __forceinline__ void dsa_phase(LAS unsigned char* lds, const _Float16* iq, const _Float16* ik, const float* iw, const bf16* dq, const bf16* dk, const bf16* dv,
                                          bf16* attn, int bid, int G, int tid, int wid, int lane) {
    asm volatile("" : "+v"(lane));
    LAS unsigned char* W = lds + wid * DSA_WREG;
    LAS unsigned* hist = (LAS unsigned*)W;
    const int r32 = lane & 31, hi = lane >> 5;
    constexpr int NT = NB * (SEQ / 32);
#pragma unroll 1
    for (int jj = 0; jj * G < NT; ++jj) {
        const int tidx = jj * G + ((jj & 1) ? (G - 1 - bid) : bid);
        if (tidx >= NT) continue;
        const int b = tidx / (SEQ / 32), qt = tidx % (SEQ / 32), t0 = 32 * qt, tw = t0 + 4 * wid;
        const size_t tokb = (size_t)b * SEQ;
        int cnt0 = 0, cnt1 = 0, cnt2 = 0, cnt3 = 0;
        {
            const int a = r32 >> 3, hr = (r32 >> 2) & 1, j4 = r32 & 3;
            const int rq = 2 * (a & 1) + hr, rh = 4 * (a >> 1) + j4;
            const _Float16* qp = iq + (tokb + tw + rq) * 512 + rh * 64 + 8 * hi;
            f16x8 qa[4];
#pragma unroll
            for (int s = 0; s < 4; ++s) qa[s] = *(const f16x8*)(qp + 16 * s);
            f16x8 w2[2];
            { const int qrow = (r32 == 0) ? 0 : (r32 == 1) ? 1 : (r32 == 4) ? 2 : (r32 == 5) ? 3 : -1;
              const f32x4 wa = *(const f32x4*)(iw + (tokb + tw + (qrow < 0 ? 0 : qrow)) * 8), wb = *(const f32x4*)(iw + (tokb + tw + (qrow < 0 ? 0 : qrow)) * 8 + 4);
#pragma unroll
              for (int s2 = 0; s2 < 2; ++s2)
#pragma unroll
                for (int j = 0; j < 8; ++j) { const float wv = s2 == 0 ? wa[j & 3] : wb[j & 3]; w2[s2][j] = (_Float16)((qrow == 2 * (j >> 2) + hi) ? wv : 0.f); } }
            LAS unsigned* kbA = (LAS unsigned*)(W + 1024 + DSA_QB * (2 * hi)); LAS unsigned short* ibA = (LAS unsigned short*)(W + 1024 + DSA_QB * (2 * hi) + DSA_IOFF);
            LAS unsigned* kbB = (LAS unsigned*)(W + 1024 + DSA_QB * (2 * hi + 1)); LAS unsigned short* ibB = (LAS unsigned short*)(W + 1024 + DSA_QB * (2 * hi + 1) + DSA_IOFF);
            LAS unsigned* dumpK = hist + lane; LAS unsigned short* dumpI = (LAS unsigned short*)(hist + 128) + lane;
            unsigned tauA = 0u, tauB = 0u;
            int cntA = 0, cntB = 0;
            const int tmaxA = tw + 2 * hi, tmaxB = tw + 2 * hi + 1;
            const int nch = qt + 1;
            const _Float16* kp = ik + tokb * 64 + lane * 8;
            f16x8 kr[DSA_RD][4];
#pragma unroll
            for (int u = 0; u < DSA_RD; ++u) { const int cl = u < nch ? u : nch - 1;
#pragma unroll
                for (int s = 0; s < 4; ++s) kr[u][s] = *(const f16x8*)(kp + (size_t)cl * 2048 + 512 * s); }
#pragma unroll 1
            for (int c = 0; c < nch; c += DSA_RD) {
                cnt0 = __builtin_amdgcn_readlane(cntA, 0); cnt1 = __builtin_amdgcn_readlane(cntB, 0); cnt2 = __builtin_amdgcn_readlane(cntA, 32); cnt3 = __builtin_amdgcn_readlane(cntB, 32);
#pragma unroll 1
                for (int q = 0; q < 4; ++q) { const int cq = q == 0 ? cnt0 : q == 1 ? cnt1 : q == 2 ? cnt2 : cnt3;
                    if (cq > DSA_C - 32 * DSA_RD) { int nc; const unsigned T = dsa_compact<false>(W + 1024 + q * DSA_QB, hist, cq, lane, nc);
                        if ((q >> 1) == hi) { if ((q & 1) == 0) { tauA = T; cntA = nc; } else { tauB = T; cntB = nc; } } } }
                f32x16 Cc = {};
#pragma unroll
                for (int s = 0; s < 4; ++s) Cc = MFMA32H(qa[s], kr[0][s], Cc);
                f32x16 Yp = {};
#pragma unroll
                for (int u = 0; u <= DSA_RD; ++u) {
                    f32x16 Cn = {};
                    if (u + 1 < DSA_RD) {
#pragma unroll
                        for (int s = 0; s < 4; ++s) Cn = MFMA32H(qa[s], kr[u + 1][s], Cn);
                    }
                    f32x16 Y = {};
                    if (u < DSA_RD) {
                        { const int cn = (c + u + DSA_RD < nch) ? (c + u + DSA_RD) : (nch - 1);
#pragma unroll
                            for (int s = 0; s < 4; ++s) kr[u][s] = *(const f16x8*)(kp + (size_t)cn * 2048 + 512 * s); }
                        f16x8 xf[2];
#pragma unroll
                        for (int s2 = 0; s2 < 2; ++s2)
#pragma unroll
                            for (int j = 0; j < 8; j += 2) { pg8::h2_t hv = __builtin_convertvector((f32x2){Cc[8 * s2 + j], Cc[8 * s2 + j + 1]}, pg8::h2_t);
                                hv = __builtin_elementwise_max(hv, (pg8::h2_t){(_Float16)0.f, (_Float16)0.f}); xf[s2][j] = hv[0]; xf[s2][j + 1] = hv[1]; }
                        Y = MFMA32H(w2[0], xf[0], Y); Y = MFMA32H(w2[1], xf[1], Y);
                    }
                    __builtin_amdgcn_sched_barrier(0);
                    if (u > 0) {
                        const float s0 = Yp[0], s1 = Yp[1];
                        const int kidx = 32 * (c + u - 1) + r32;
                        const unsigned k0 = (kidx <= tmaxA) ? okey(s0) : 0u, k1 = (kidx <= tmaxB) ? okey(s1) : 0u;
                        const bool p0 = k0 > tauA, p1 = k1 > tauB;
                        const unsigned long long b0 = __ballot(p0), b1 = __ballot(p1);
                        const unsigned lo0 = (unsigned)b0, hi0 = (unsigned)(b0 >> 32), lo1 = (unsigned)b1, hi1 = (unsigned)(b1 >> 32);
                        const int pos0 = cntA + (int)__builtin_amdgcn_mbcnt_hi(hi0, __builtin_amdgcn_mbcnt_lo(hi ? 0u : lo0, 0u));
                        const int pos1 = cntB + (int)__builtin_amdgcn_mbcnt_hi(hi1, __builtin_amdgcn_mbcnt_lo(hi ? 0u : lo1, 0u));
                        LAS unsigned* ka = p0 ? (kbA + pos0) : dumpK; LAS unsigned short* ia = p0 ? (ibA + pos0) : dumpI;
                        LAS unsigned* kb_ = p1 ? (kbB + pos1) : dumpK; LAS unsigned short* ib_ = p1 ? (ibB + pos1) : dumpI;
                        *ka = k0; *ia = (unsigned short)kidx; *kb_ = k1; *ib_ = (unsigned short)kidx;
                        cntA += __builtin_popcount(hi ? hi0 : lo0); cntB += __builtin_popcount(hi ? hi1 : lo1);
                    }
                    __builtin_amdgcn_sched_barrier(0);
                    Cc = Cn; Yp = Y;
                }
            }
            asm volatile("s_waitcnt lgkmcnt(0)" ::: "memory");
            cnt0 = __builtin_amdgcn_readlane(cntA, 0); cnt1 = __builtin_amdgcn_readlane(cntB, 0); cnt2 = __builtin_amdgcn_readlane(cntA, 32); cnt3 = __builtin_amdgcn_readlane(cntB, 32);
#pragma unroll 1
            for (int q = 0; q < 4; ++q) { const int cq = q == 0 ? cnt0 : q == 1 ? cnt1 : q == 2 ? cnt2 : cnt3;
                if (cq > 256) { int nc; dsa_compact<true>(W + 1024 + q * DSA_QB, hist, cq, lane, nc);
                    cnt0 = q == 0 ? 256 : cnt0; cnt1 = q == 1 ? 256 : cnt1; cnt2 = q == 2 ? 256 : cnt2; cnt3 = q == 3 ? 256 : cnt3; } }
        }
        {
            unsigned short idxr[4][4];
#pragma unroll
            for (int q = 0; q < 4; ++q) { const int Lq = q == 0 ? cnt0 : q == 1 ? cnt1 : q == 2 ? cnt2 : cnt3;
#pragma unroll
                for (int i = 0; i < 4; ++i) { const int e = i * 64 + lane; idxr[q][i] = 0; if (e < Lq) idxr[q][i] = ((LAS unsigned short*)(W + 1024 + DSA_QB * q + DSA_IOFF))[e]; } }
            asm volatile("s_waitcnt lgkmcnt(0)" ::: "memory");
#pragma unroll
            for (int q = 0; q < 4; ++q)
#pragma unroll
                for (int i = 0; i < 4; ++i) ((LAS unsigned short*)W)[q * 256 + i * 64 + lane] = idxr[q][i];
            asm volatile("s_waitcnt lgkmcnt(0)" ::: "memory");
        }
        {
            __builtin_amdgcn_s_setprio(1);
            const LAS unsigned short* list16 = (const LAS unsigned short*)W;
            LAS unsigned char* Vs = W + 2048;
            const int hd = lane & 15, quad = lane >> 4, q4 = (lane & 15) >> 2, p4 = lane & 3;
#pragma unroll 1
            for (int q = 0; q < 4; ++q) {
                const int L = q == 0 ? cnt0 : q == 1 ? cnt1 : q == 2 ? cnt2 : cnt3;
                const int t = tw + q;
                bf16x8 qb[2];
#pragma unroll
                for (int ks = 0; ks < 2; ++ks) { qb[ks] = (bf16x8){0, 0, 0, 0, 0, 0, 0, 0}; if (hd < 8) qb[ks] = *(const bf16x8*)(dq + (tokb + t) * 512 + hd * 64 + 32 * ks + 8 * quad); }
                f32x4 O[4];
#pragma unroll
                for (int dt = 0; dt < 4; ++dt) O[dt] = (f32x4){0.f, 0.f, 0.f, 0.f};
                float mrun = -INFINITY, lrun = 0.f;
#pragma unroll 1
                for (int half = 0; half < 2; ++half) {
                    const LAS unsigned short* ml = list16 + q * 256 + 128 * half;
                    asm volatile("s_waitcnt lgkmcnt(0)" ::: "memory");
                    u32x4 vreg[16]; bf16x8 kreg[8][2];
#pragma unroll
                    for (int c = 0; c < 8; ++c) { const unsigned tk = ml[16 * c + hd]; const bf16* kp2 = dk + (tokb + tk) * 64 + 8 * quad;
                        kreg[c][0] = *(const bf16x8*)kp2; kreg[c][1] = *(const bf16x8*)(kp2 + 32); }
#pragma unroll
                    for (int it = 0; it < 16; ++it) { const int idx = it * 64 + lane, r = idx >> 3, cc = idx & 7; const unsigned tk = ml[r];
                        vreg[it] = *(const u32x4*)(dv + (tokb + tk) * 64 + 8 * cc); }
                    f32x4 Sc[8];
#pragma unroll
                    for (int c = 0; c < 8; ++c) { f32x4 z = {0.f, 0.f, 0.f, 0.f}; z = MFMA16BF(kreg[c][0], qb[0], z); Sc[c] = MFMA16BF(kreg[c][1], qb[1], z); }
#pragma unroll
                    for (int it = 0; it < 16; ++it) { const int idx = it * 64 + lane, r = idx >> 3, cc = idx & 7; *(LAS u32x4*)(Vs + r * 128 + cc * 16) = vreg[it]; }
                    float mloc = -INFINITY;
#pragma unroll
                    for (int c = 0; c < 8; ++c)
#pragma unroll
                        for (int e = 0; e < 4; ++e) { const int li = 128 * half + 16 * c + 4 * quad + e; float xv = Sc[c][e] * (0.125f * LOG2E); if (li >= L) xv = -INFINITY; Sc[c][e] = xv; mloc = fmaxf(mloc, xv); }
                    mloc = fmaxf(mloc, __shfl_xor(mloc, 16)); mloc = fmaxf(mloc, __shfl_xor(mloc, 32));
                    const float mnew = fmaxf(mrun, mloc);
                    const float fsc = __builtin_amdgcn_exp2f(mrun - mnew);
                    mrun = mnew;
                    float lsum = 0.f;
#pragma unroll
                    for (int c = 0; c < 8; ++c)
#pragma unroll
                        for (int e = 0; e < 4; ++e) { const float p = __builtin_amdgcn_exp2f(Sc[c][e] - mnew); Sc[c][e] = p; lsum += p; }
                    lsum += __shfl_xor(lsum, 16); lsum += __shfl_xor(lsum, 32);
                    lrun = lrun * fsc + lsum;
#pragma unroll
                    for (int e = 0; e < 4; ++e) { const float f = __shfl(fsc, (4 * quad + e) & 15);
#pragma unroll
                        for (int dt = 0; dt < 4; ++dt) O[dt][e] *= f; }
                    asm volatile("s_waitcnt lgkmcnt(0)" ::: "memory");
#pragma unroll
                    for (int kk = 0; kk < 4; ++kk) {
                        const int c0 = 2 * kk;
                        u32x4 pw; pw.x = pkbf(Sc[c0][0], Sc[c0][1]); pw.y = pkbf(Sc[c0][2], Sc[c0][3]); pw.z = pkbf(Sc[c0 + 1][0], Sc[c0 + 1][1]); pw.w = pkbf(Sc[c0 + 1][2], Sc[c0 + 1][3]);
                        const bf16x8 pa = __builtin_bit_cast(bf16x8, pw);
#pragma unroll
                        for (int dt = 0; dt < 4; ++dt) {
                            const v4i16_t lo = trrd(Vs + (32 * kk + 4 * quad + q4) * 128 + (16 * dt + 4 * p4) * 2);
                            const v4i16_t hi4 = trrd(Vs + (32 * kk + 16 + 4 * quad + q4) * 128 + (16 * dt + 4 * p4) * 2);
                            const bf16x8 vb = (bf16x8){lo[0], lo[1], lo[2], lo[3], hi4[0], hi4[1], hi4[2], hi4[3]};
                            O[dt] = MFMA16BF(pa, vb, O[dt]);
                        }
                    }
                }
#pragma unroll
                for (int e = 0; e < 4; ++e) { const float l = __shfl(lrun, (4 * quad + e) & 15); const float rl = 1.f / l;
                    if (quad < 2) {
#pragma unroll
                        for (int dt = 0; dt < 4; ++dt) attn[(tokb + t) * 1024 + (4 * quad + e) * 64 + 16 * dt + hd] = (bf16)(pkbf(O[dt][e] * rl, 0.f) & 0xffffu); } }
            }
            asm volatile("s_waitcnt lgkmcnt(0)" ::: "memory");
            __builtin_amdgcn_s_setprio(0);
        }
    }
}

__device__ __forceinline__ void swa_phase(LAS unsigned char* lds, const bf16* sq, const bf16* sk, const bf16* sv, const float* sinks, bf16* attn, int bid, int G, int wid, int lane) {
    asm volatile("" : "+v"(lane));
    LAS unsigned char* Vs = lds + wid * 4096;
    const int r32 = lane & 31, hi = lane >> 5;
    const int g16 = (lane >> 4) & 1, q4 = (lane & 15) >> 2, p4 = lane & 3;
    constexpr int NU = NB * 8 * (SEQ / 32);
    for (int u = bid * NWAVES + wid; u < NU; u += G * NWAVES) {
        const int qb = u & 255, hq = (u >> 8) & 7, b = u >> 11, hk = hq >> 2;
        const int q0 = 32 * qb; const size_t tokb = (size_t)b * SEQ;
        const float sink2 = sinks[hq] * LOG2E;
        bf16x8 qf[4];
#pragma unroll
        for (int s = 0; s < 4; ++s) qf[s] = *(const bf16x8*)(sq + (tokb + q0 + r32) * 512 + hq * 64 + 16 * s + 8 * hi);
        f32x16 Sc[5];
#pragma unroll
        for (int c = 0; c < 5; ++c) { int kt = q0 - 128 + 32 * c + r32; kt = kt < 0 ? 0 : kt; const bf16* kp = sk + (tokb + kt) * 128 + hk * 64 + 8 * hi;
            f32x16 acc = {};
#pragma unroll
            for (int s = 0; s < 4; ++s) acc = MFMA32BF(*(const bf16x8*)(kp + 16 * s), qf[s], acc);
            Sc[c] = acc; }
        const int qpos = q0 + r32;
        float m = sink2;
#pragma unroll
        for (int c = 0; c < 5; ++c)
#pragma unroll
            for (int e = 0; e < 16; ++e) { const int kpos = q0 - 128 + 32 * c + crow(e, hi); const int diff = qpos - kpos; float xv = Sc[c][e] * (0.125f * LOG2E);
                if (!(diff >= 0 && diff < 128 && kpos >= 0)) xv = -INFINITY; Sc[c][e] = xv; m = fmaxf(m, xv); }
        m = fmaxf(m, __shfl_xor(m, 32));
        float l = 0.f;
#pragma unroll
        for (int c = 0; c < 5; ++c)
#pragma unroll
            for (int e = 0; e < 16; ++e) { const float p = __builtin_amdgcn_exp2f(Sc[c][e] - m); Sc[c][e] = p; l += p; }
        l += __shfl_xor(l, 32);
        l += __builtin_amdgcn_exp2f(sink2 - m);
        f32x16 O[2]; O[0] = (f32x16){}; O[1] = (f32x16){};
#pragma unroll
        for (int c = 0; c < 5; ++c) {
            asm volatile("s_waitcnt lgkmcnt(0)" ::: "memory");
#pragma unroll
            for (int it = 0; it < 4; ++it) { const int idx = it * 64 + lane, rr = idx >> 3, cc = idx & 7; int kt = q0 - 128 + 32 * c + rr; kt = kt < 0 ? 0 : kt;
                const u32x4 v = *(const u32x4*)(sv + (tokb + kt) * 128 + hk * 64 + 8 * cc); *(LAS u32x4*)(Vs + rr * 128 + cc * 16) = v; }
            asm volatile("s_waitcnt lgkmcnt(0)" ::: "memory");
#pragma unroll
            for (int s2 = 0; s2 < 2; ++s2) {
                u32x4 pw; pw.x = pkbf(Sc[c][8 * s2], Sc[c][8 * s2 + 1]); pw.y = pkbf(Sc[c][8 * s2 + 2], Sc[c][8 * s2 + 3]); pw.z = pkbf(Sc[c][8 * s2 + 4], Sc[c][8 * s2 + 5]); pw.w = pkbf(Sc[c][8 * s2 + 6], Sc[c][8 * s2 + 7]);
                const bf16x8 pb = __builtin_bit_cast(bf16x8, pw);
#pragma unroll
                for (int dt = 0; dt < 2; ++dt) {
                    const v4i16_t lo = trrd(Vs + (16 * s2 + 4 * hi + q4) * 128 + (32 * dt + 16 * g16 + 4 * p4) * 2);
                    const v4i16_t hi4 = trrd(Vs + (16 * s2 + 8 + 4 * hi + q4) * 128 + (32 * dt + 16 * g16 + 4 * p4) * 2);
                    const bf16x8 va = (bf16x8){lo[0], lo[1], lo[2], lo[3], hi4[0], hi4[1], hi4[2], hi4[3]};
                    O[dt] = MFMA32BF(va, pb, O[dt]);
                }
            }
        }
        const float rl = 1.f / l;
        bf16* op = attn + (tokb + q0 + r32) * 1024 + 512 + hq * 64;
#pragma unroll
        for (int dt = 0; dt < 2; ++dt)
#pragma unroll
            for (int a = 0; a < 4; ++a) { u32x2 w; w.x = pkbf(O[dt][4 * a] * rl, O[dt][4 * a + 1] * rl); w.y = pkbf(O[dt][4 * a + 2] * rl, O[dt][4 * a + 3] * rl);
                *(u32x2*)(op + 32 * dt + 8 * a + 4 * hi) = w; }
    }
    asm volatile("s_waitcnt lgkmcnt(0)" ::: "memory");
}

__device__ __forceinline__ void xattn_phase(LAS unsigned char* lds, const bf16* qmem, const bf16* memkv, const bf16* memkf, bf16* catt, int bid, int G, int tid, int wid, int lane, int usel = -1) {
    asm volatile("" : "+v"(lane), "+v"(tid));
    constexpr int VROW = 320;
    const int r32 = lane & 31, hi = lane >> 5;
    const int g16 = (lane >> 4) & 1, q4 = (lane & 15) >> 2, p4 = lane & 3;
    for (int u = (usel >= 0 ? usel : bid); u < 512; u += (usel >= 0 ? 512 : G)) {
        const int qt = u & 31, head = (u >> 5) & 3, b = u >> 7;
        const size_t tok0 = (size_t)b * SEQ + 256 * qt + 32 * wid;
        const bf16* kbase = memkv + (size_t)(b * MEMT) * 2048 + head * 256;
        const bf16* kfb = memkf + (size_t)(b * 4 + head) * 128 * 512 + lane * 8;
        f32x16 Sc[8];
#pragma unroll
        for (int c = 0; c < 8; ++c) Sc[c] = (f32x16){};
#pragma unroll 2
        for (int s = 0; s < 16; ++s) {
            const bf16x8 qf = *(const bf16x8*)(qmem + (tok0 + r32) * 1024 + head * 256 + 16 * s + 8 * hi);
#pragma unroll
            for (int c = 0; c < 8; ++c) { const bf16x8 kf = *(const bf16x8*)(kfb + (size_t)(c * 16 + s) * 512); Sc[c] = MFMA32BF(kf, qf, Sc[c]); }
        }
        float m = -INFINITY;
#pragma unroll
        for (int c = 0; c < 8; ++c)
#pragma unroll
            for (int e = 0; e < 16; ++e) { const float xv = Sc[c][e] * LOG2E; Sc[c][e] = xv; m = fmaxf(m, xv); }
        m = fmaxf(m, __shfl_xor(m, 32));
        float l = 0.f;
#pragma unroll
        for (int c = 0; c < 8; ++c)
#pragma unroll
            for (int e = 0; e < 16; ++e) { const float p = __builtin_amdgcn_exp2f(Sc[c][e] - m); Sc[c][e] = p; l += p; }
        l += __shfl_xor(l, 32);
        const float rl = 1.f / l;
        bf16x8 pb[8][2];
#pragma unroll
        for (int c = 0; c < 8; ++c)
#pragma unroll
            for (int s2 = 0; s2 < 2; ++s2) { u32x4 pw; pw.x = pkbf(Sc[c][8 * s2], Sc[c][8 * s2 + 1]); pw.y = pkbf(Sc[c][8 * s2 + 2], Sc[c][8 * s2 + 3]); pw.z = pkbf(Sc[c][8 * s2 + 4], Sc[c][8 * s2 + 5]); pw.w = pkbf(Sc[c][8 * s2 + 6], Sc[c][8 * s2 + 7]);
                pb[c][s2] = __builtin_bit_cast(bf16x8, pw); }
#pragma unroll 1
        for (int dh = 0; dh < 2; ++dh) {
            __syncthreads();
#pragma unroll
            for (int it = 0; it < 8; ++it) { const int idx = it * NTHR + tid, rr = idx >> 4, cc = idx & 15;
                const u32x4 v = *(const u32x4*)(kbase + (size_t)rr * 2048 + 1024 + 128 * dh + 8 * cc); *(LAS u32x4*)(lds + rr * VROW + cc * 16) = v; }
            __syncthreads();
            f32x16 O[4];
#pragma unroll
            for (int dt = 0; dt < 4; ++dt) O[dt] = (f32x16){};
#pragma unroll
            for (int c = 0; c < 8; ++c)
#pragma unroll
                for (int s2 = 0; s2 < 2; ++s2)
#pragma unroll
                    for (int dt = 0; dt < 4; ++dt) {
                        const v4i16_t lo = trrd(lds + (32 * c + 16 * s2 + 4 * hi + q4) * VROW + (32 * dt + 16 * g16 + 4 * p4) * 2);
                        const v4i16_t hi4 = trrd(lds + (32 * c + 16 * s2 + 8 + 4 * hi + q4) * VROW + (32 * dt + 16 * g16 + 4 * p4) * 2);
                        const bf16x8 va = (bf16x8){lo[0], lo[1], lo[2], lo[3], hi4[0], hi4[1], hi4[2], hi4[3]};
                        O[dt] = MFMA32BF(va, pb[c][s2], O[dt]);
                    }
            bf16* op = catt + (tok0 + r32) * 1024 + head * 256 + 128 * dh;
#pragma unroll
            for (int dt = 0; dt < 4; ++dt)
#pragma unroll
                for (int a = 0; a < 4; ++a) { u32x2 w; w.x = pkbf(O[dt][4 * a] * rl, O[dt][4 * a + 1] * rl); w.y = pkbf(O[dt][4 * a + 2] * rl, O[dt][4 * a + 3] * rl);
                    *(u32x2*)(op + 32 * dt + 8 * a + 4 * hi) = w; }
        }
    }
    __syncthreads();
}

#define XB_TMO      128
#define XB_XCNT(j)  (256  + 64 * (j))
#define XB_XSUB(j)  (1280 + 64 * (j))
#define XB_XGEN(j)  (2304 + 64 * (j))
#define XB_TOP      3328
#define XB_TOPGEN   3392
#define XCD_BAR_WORDS 3456
#define XB_SPIN_CAP (1u << 18)

__device__ __forceinline__ unsigned xb_ld(unsigned* p)              { return __hip_atomic_load(p, __ATOMIC_RELAXED, __HIP_MEMORY_SCOPE_AGENT); }
__device__ __forceinline__ unsigned xb_add(unsigned* p, unsigned v) { return __hip_atomic_fetch_add(p, v, __ATOMIC_RELAXED, __HIP_MEMORY_SCOPE_AGENT); }
__device__ __forceinline__ unsigned xb_xcc_id() { return (unsigned)__builtin_amdgcn_s_getreg((3 << 11) | 20) & 0xFu; }
#define XB_SPIN(cond, bar) do { unsigned _sp = 0; while (cond) { __builtin_amdgcn_s_sleep(1); \
    if ((++_sp & 255u) == 0u) { if (xb_ld(&(bar)[XB_TMO])) break; if (_sp > XB_SPIN_CAP) { atomicAdd(&(bar)[XB_TMO], 1u); break; } } } } while (0)

struct XcdBarrier {
    unsigned* bar; unsigned x;
    volatile LAS unsigned* st;
};

__device__ __forceinline__ XcdBarrier xcd_barrier_post(unsigned* bar, volatile LAS unsigned* st) {
    XcdBarrier b; b.bar = bar; b.x = xb_xcc_id(); b.st = st;
    if (threadIdx.x == 0) (void)xb_add(&bar[XB_XCNT(b.x)], 1u);
    return b;
}
__device__ __forceinline__ void xcd_barrier_complete(unsigned* bar, unsigned x, unsigned& nloc, unsigned& nx) {
    const unsigned G = gridDim.x * gridDim.y * gridDim.z;
    unsigned sum, cnt, mine, sp = 0u;
    for (;;) {
        sum = 0u; cnt = 0u; mine = 0u;
#pragma unroll
        for (unsigned j = 0; j < 16; ++j) { const unsigned c = xb_ld(&bar[XB_XCNT(j)]); sum += c; cnt += (c > 0u) ? 1u : 0u; mine = (j == x) ? c : mine; }
        if (sum == G) break;
        __builtin_amdgcn_s_sleep(1);
        if ((++sp & 255u) == 0u) { if (xb_ld(&bar[XB_TMO])) break; if (sp > XB_SPIN_CAP) { atomicAdd(&bar[XB_TMO], 1u); break; } }
    }
    nloc = mine > 0u ? mine : 1u; nx = cnt > 0u ? cnt : 1u;
}

__device__ __forceinline__ void xcd_barrier(const XcdBarrier& b) {
    asm volatile("s_waitcnt vmcnt(0)" ::: "memory");
    __syncthreads();
    if (threadIdx.x == 0) {
        unsigned* bar = b.bar;
        __builtin_amdgcn_s_waitcnt(0);
        unsigned nloc = b.st[0], nx = b.st[1];
        if (nloc == 0u) { xcd_barrier_complete(bar, b.x, nloc, nx); b.st[0] = nloc; b.st[1] = nx; }
        const unsigned old = xb_add(&bar[XB_XSUB(b.x)], 1u);
        const unsigned gen = old / nloc;
        if (old + 1u == (gen + 1u) * nloc) {
            __builtin_amdgcn_fence(__ATOMIC_RELEASE, "agent");
            asm volatile("s_waitcnt vmcnt(0)" ::: "memory");
            const unsigned og = xb_add(&bar[XB_TOP], 1u);
            const unsigned tg = og / nx;
            if (og + 1u == (tg + 1u) * nx) xb_add(&bar[XB_TOPGEN], 1u);
            else XB_SPIN(xb_ld(&bar[XB_TOPGEN]) == tg, bar);
            __builtin_amdgcn_fence(__ATOMIC_ACQUIRE, "agent");
            xb_add(&bar[XB_XGEN(b.x)], 1u);
            asm volatile("s_waitcnt vmcnt(0)" ::: "memory");
        } else {
            XB_SPIN(xb_ld(&bar[XB_XGEN(b.x)]) == gen, bar);
            __builtin_amdgcn_fence(__ATOMIC_ACQUIRE, "agent");
            asm volatile("s_waitcnt vmcnt(0)" ::: "memory");
        }
    }
    __syncthreads();
}

#ifndef REP_P1
#define REP_P1 1
#endif
#ifndef REP_SWA
#define REP_SWA 1
#endif
#ifndef REP_DSA
#define REP_DSA 1
#endif
#ifndef REP_XA
#define REP_XA 1
#endif
#ifndef REP_LN
#define REP_LN 1
#endif
#ifndef REP_FF
#define REP_FF 1
#endif
#ifndef REP_P0
#define REP_P0 1
#endif
#define PHASE_PTRS \
    __attribute__((address_space(1))) unsigned char* ws0_ = (__attribute__((address_space(1))) unsigned char*)P.ws; asm volatile("" : "+s"(ws0_)); unsigned char* ws = (unsigned char*)ws0_;     \
    bf16* w_in_t = (bf16*)(ws + WS_WIN); bf16* w_o_t = (bf16*)(ws + WS_WO); bf16* wq_t = (bf16*)(ws + WS_WQ); bf16* wkv_t = (bf16*)(ws + WS_WKV); \
    bf16* wom_t = (bf16*)(ws + WS_WOM); bf16* wup_t = (bf16*)(ws + WS_WUP); bf16* wdn_t = (bf16*)(ws + WS_WDN); \
    bf16* memb = (bf16*)(ws + WS_MEMB); bf16* memkv = (bf16*)(ws + WS_MEMKV); bf16* memkf = (bf16*)(ws + WS_MEMKF); (void)memkf; \
    float* cosT = (float*)(ws + WS_COS); float* sinT = (float*)(ws + WS_SIN); \
    f32x2* st1 = (f32x2*)(ws + WS_ST1); f32x2* st2 = (f32x2*)(ws + WS_ST2); \
    bf16* ra = (bf16*)(ws + WS_RA); \
    bf16* dq = (bf16*)(ws + WS_DQ); bf16* sqb = (bf16*)(ws + WS_SQ); _Float16* iq = (_Float16*)(ws + WS_IQ); bf16* dk = (bf16*)(ws + WS_DK); bf16* dv = (bf16*)(ws + WS_DV); \
    _Float16* ik = (_Float16*)(ws + WS_IK); bf16* skb = (bf16*)(ws + WS_SK); bf16* svb = (bf16*)(ws + WS_SV); float* iw = (float*)(ws + WS_IW); \
    bf16* y1 = (bf16*)(ws + WS_RC); bf16* y2 = (bf16*)(ws + WS_RB);     \
    bf16* hb1 = (bf16*)(ws + WS_RD); bf16* catt = (bf16*)(ws + WS_RE); bf16* ffb = (bf16*)(ws + WS_RC); \
    (void)w_in_t; (void)w_o_t; (void)wq_t; (void)wkv_t; (void)wom_t; (void)wup_t; (void)wdn_t; (void)memb; (void)memkv; (void)cosT; (void)sinT; (void)st1; (void)st2; (void)ra; \
    (void)dq; (void)sqb; (void)iq; (void)dk; (void)dv; (void)ik; (void)skb; (void)svb; (void)iw; (void)y1; (void)y2; (void)hb1; (void)catt; (void)ffb;
__global__ void __launch_bounds__(NTHR, 2) fwd_megakernel(Params P) {
    extern __shared__ __attribute__((aligned(16))) unsigned char lds_raw[];
    cg::grid_group grid = cg::this_grid();
    LAS unsigned char* lds = (LAS unsigned char*)lds_raw;
    const int tid = threadIdx.x, lane = tid & 63, wid = __builtin_amdgcn_readfirstlane(tid >> 6);
    const int bid = blockIdx.x, G = gridDim.x;
    const int gw = bid * NWAVES + wid, NGW = G * NWAVES;

    volatile LAS unsigned* MISC = (volatile LAS unsigned*)(lds + MISC_OFF);
    if (tid < 32) MISC[tid] = 0u;
    __syncthreads();
    const XcdBarrier xbar = xcd_barrier_post((unsigned*)P.ws, MISC + 8);
    {
    PHASE_PTRS
    for (int rep = 0; rep < REP_P0; ++rep) { p0_prologue(P, lds, bid, G, tid, wid, lane); __syncthreads(); }
    }
    grid.sync();
    {
    PHASE_PTRS
    for (int rep = 0; rep < REP_P1; ++rep)
    { pg8::Gemm g{ra, w_in_t, MTOK, NPROJ, DM}; pg8::StaticOrder S; S.init(MTOK, NPROJ, G, bid);
      pg8::EpiInProj E{P.b_in, cosT, sinT, dq, dk, dv, sqb, skb, svb, iq, ik, iw};
      pg8::gemm_phase<pg8::EpiInProj, pg8::StaticOrder, true, true>(lds, g, S, E); }
    }
    xcd_barrier(xbar);
    {
    PHASE_PTRS
    for (int rep = 0; rep < REP_SWA; ++rep) { swa_phase(lds, sqb, skb, svb, P.sinks, ra, bid, G, wid, lane); __syncthreads(); }
    for (int rep = 0; rep < REP_DSA; ++rep) dsa_phase(lds, iq, ik, iw, dq, dk, dv, ra, bid, G, tid, wid, lane);
    }
    xcd_barrier(xbar);
    {
    PHASE_PTRS
    { pg8::Gemm g{ra, w_o_t, MTOK, DM, DM}; pg8::StaticOrder S; S.init(MTOK, DM, G, bid);
      pg8::EpiRes<false, float, bf16> E{P.x, y1, nullptr, nullptr, nullptr, ALPHA};
      pg8::gemm_phase<pg8::EpiRes<false, float, bf16>, pg8::StaticOrder, true, true>(lds, g, S, E); }
    }
    xcd_barrier(xbar);
    {
    PHASE_PTRS
    if (G > 64) {
      if (bid < 32) { pg8::Gemm g{memb, wkv_t, MROWS, 2048, DM}; pg8::StaticOrder S; S.init(MROWS, 2048, 32, bid);
        pg8::EpiMemKV E{memkf, memkv};
        pg8::gemm_phase<pg8::EpiMemKV, pg8::StaticOrder, true, true>(lds, g, S, E); }
      else ln_pass(y1, P.ln1g, P.ln1b, hb1, st1, nullptr, (bid - 32) * NWAVES + wid, (G - 32) * NWAVES, lane);
    } else {
      { pg8::Gemm g{memb, wkv_t, MROWS, 2048, DM}; pg8::StaticOrder S; S.init(MROWS, 2048, G, bid);
        pg8::EpiMemKV E{memkf, memkv};
        pg8::gemm_phase<pg8::EpiMemKV, pg8::StaticOrder, true, true>(lds, g, S, E); }
      ln_pass(y1, P.ln1g, P.ln1b, hb1, st1, nullptr, gw, NGW, lane);
    }
    }
    xcd_barrier(xbar);
    {
    PHASE_PTRS
    { pg8::Gemm g{hb1, wq_t, MTOK, DM, DM}; pg8::StaticOrder S; S.init(MTOK, DM, G, bid);
      pg8::EpiBf16<0> E{ra, DM, 0.0625f};
#pragma unroll 1
      for (int i = 0; ; ++i) { pg8::Unit u; if (!S.next(i, u)) break;
          pg8::OneUnit S1{u};
          pg8::gemm_phase<pg8::EpiBf16<0>, pg8::OneUnit, true, true>(lds, g, S1, E);
          asm volatile("s_waitcnt vmcnt(0)" ::: "memory"); __syncthreads();
          xattn_phase(lds, ra, memkv, memkf, catt, bid, G, tid, wid, lane, ((u.pm >> 5) << 7) | (u.pn << 5) | (u.pm & 31)); } }
    }
    xcd_barrier(xbar);
    {
    PHASE_PTRS
    { pg8::Gemm g{catt, wom_t, MTOK, DM, DM}; pg8::StaticOrder S; S.init(MTOK, DM, G, bid);
      pg8::EpiRes<true, bf16, bf16> E{y1, y2, st1, P.ln1g, P.ln1b, ALPHA};
      pg8::gemm_phase<pg8::EpiRes<true, bf16, bf16>, pg8::StaticOrder, true, true>(lds, g, S, E); }
    }
    xcd_barrier(xbar);
    {
    PHASE_PTRS
    ln_pass(y2, P.ln2g, P.ln2b, ra, st2, nullptr, gw, NGW, lane);
    }
    xcd_barrier(xbar);
    {
    PHASE_PTRS
    for (int rep = 0; rep < REP_FF; ++rep)
    { pg8::Gemm g{ra, wup_t, MTOK, FF, DM}; pg8::StaticOrder S; S.init(MTOK, FF, G, bid);
      pg8::EpiBf16<2> E{ffb, FF, 1.f};
      pg8::gemm_phase<pg8::EpiBf16<2>, pg8::StaticOrder, true, true>(lds, g, S, E); }
    }
    xcd_barrier(xbar);
    {
    PHASE_PTRS
    { pg8::Gemm g{ffb, wdn_t, MTOK, DM, FF}; pg8::StaticOrder S; S.init(MTOK, DM, G, bid);
      pg8::EpiRes<true, bf16, bf16> E{y2, ra, st2, P.ln2g, P.ln2b, ALPHA};
      pg8::gemm_phase<pg8::EpiRes<true, bf16, bf16>, pg8::StaticOrder, true, true>(lds, g, S, E); }
    }
    xcd_barrier(xbar);
    {
    PHASE_PTRS
    ln_pass(ra, P.ln3g, P.ln3b, nullptr, nullptr, P.out, gw, NGW, lane);
    }
}

extern "C" void kernel_launch(void* const* d_in, const int* in_sizes, int n_in, void* d_out, int out_size, void* d_ws, size_t ws_size, hipStream_t stream) {
    static int grid = 0;
    if (grid == 0) {
        if (n_in != 19 || in_sizes[0] != MTOK * DM || out_size != MTOK * DM || ws_size < WS_END) { fprintf(stderr, "kernel_launch: unexpected shapes (n_in %d, in0 %d, out %d, ws %zu)\n", n_in, n_in > 0 ? in_sizes[0] : -1, out_size, ws_size); grid = -1; return; }
        int dev = 0, cus = 0, per_cu = 0;
        hipGetDevice(&dev);
        hipDeviceGetAttribute(&cus, hipDeviceAttributeMultiprocessorCount, dev);
        if (hipFuncSetAttribute((const void*)fwd_megakernel, hipFuncAttributeMaxDynamicSharedMemorySize, LDS_BYTES) != hipSuccess) { fprintf(stderr, "kernel_launch: hipFuncSetAttribute failed\n"); grid = -1; return; }
        if (hipOccupancyMaxActiveBlocksPerMultiprocessor(&per_cu, (const void*)fwd_megakernel, NTHR, LDS_BYTES) != hipSuccess || per_cu < 1) { fprintf(stderr, "kernel_launch: occupancy query says %d blocks per CU\n", per_cu); per_cu = 1; }
        (void)hipGetLastError();
        grid = cus * 1;
        fprintf(stderr, "kernel_launch: cus %d per_cu %d grid %d\n", cus, per_cu, grid);
    }
    if (grid < 0) return;
    Params p{};
    p.x = (const float*)d_in[0]; p.mem = (const float*)d_in[1]; p.pos = (const int*)d_in[2]; p.w_in = (const float*)d_in[3]; p.b_in = (const float*)d_in[4];
    p.sinks = (const float*)d_in[5]; p.w_o = (const float*)d_in[6]; p.ln1g = (const float*)d_in[7]; p.ln1b = (const float*)d_in[8];
    p.wq = (const float*)d_in[9]; p.wk = (const float*)d_in[10]; p.wv = (const float*)d_in[11]; p.wom = (const float*)d_in[12];
    p.ln2g = (const float*)d_in[13]; p.ln2b = (const float*)d_in[14]; p.wup = (const float*)d_in[15]; p.wdn = (const float*)d_in[16];
    p.ln3g = (const float*)d_in[17]; p.ln3b = (const float*)d_in[18];
    p.out = (float*)d_out; p.ws = (unsigned char*)d_ws;
    if (hipMemsetAsync(d_ws, 0, 16384, stream) != hipSuccess) { fprintf(stderr, "kernel_launch: memset failed\n"); return; }
    void* args[] = {&p};
    hipError_t e = hipLaunchCooperativeKernel((const void*)fwd_megakernel, dim3(grid), dim3(NTHR), args, LDS_BYTES, stream);
    if (e != hipSuccess) fprintf(stderr, "kernel_launch: cooperative launch failed: %s (grid %d)\n", hipGetErrorString(e), grid);
}
```

```cpp
#include <hip/hip_runtime.h>
#include <hip/hip_cooperative_groups.h>
#include <cstdio>
#include <cstdint>
namespace cg = cooperative_groups;

namespace pg8 {
#define PG8_LAS __attribute__((address_space(3)))
typedef unsigned short bf16_t;
typedef short bf16x8 __attribute__((ext_vector_type(8)));
typedef float f32x4 __attribute__((ext_vector_type(4)));
typedef unsigned u32x4 __attribute__((ext_vector_type(4)));
constexpr int BM = 256, BK = 64, HALF = 128, HTB = HALF * BK * 2  , STAGE_BYTES = 8 * HTB, NXCD = 8, WGM = 8;

__host__ __device__ __forceinline__ int lds_byte(int r, int c) { const int st = (r >> 4) * 2 + (c >> 5), rr = r & 15, cc = c & 31, ob = rr * 64 + cc * 2; return st * 1024 + (ob ^ (((ob >> 9) & 1) << 5)); }
__host__ __device__ __forceinline__ void stage_rc(int b, int& R, int& C) { const int st = b / 1024, sb = b % 1024, swz = sb ^ (((sb >> 9) & 1) << 5); R = (st >> 1) * 16 + swz / 64; C = (st & 1) * 32 + (swz % 64) / 2; }
__host__ __device__ __forceinline__ int perm32(int rho) { const int n = rho >> 4, i = rho & 15; return 8 * (i >> 2) + 4 * n + (i & 3); }

struct Unit { int pm, pn; };
struct Gemm { const bf16_t* A; const bf16_t* Bt; int M, N, K; };

struct StaticOrder {
    int nM, nN, nwg, G, c;
    __host__ __device__ void init(int M, int N, int G_, int c_) { nM = M / BM; nN = N / BM; nwg = nM * nN; G = G_; c = c_; }
    __host__ __device__ bool next(int i, Unit& u) const {
        const long L = (long)i * G + c; if (L >= nwg) return false;
        int wgid = (int)L; { const int q = nwg / NXCD, r = nwg % NXCD, xcd = wgid % NXCD, off = wgid / NXCD; wgid = (xcd < r ? xcd * (q + 1) : r * (q + 1) + (xcd - r) * q) + off; }
        const int nig = WGM * nN, gid = wgid / nig, fm = gid * WGM, gsz = (nM - fm) < WGM ? (nM - fm) : WGM;
        u.pm = fm + ((wgid % nig) % gsz); u.pn = (wgid % nig) / gsz; return true;
    }
    __device__ __forceinline__ void a_ready(const Unit&) const {}
    __device__ __forceinline__ void done(const Unit&) const {}
};

struct OneUnit { Unit u; __device__ __forceinline__ bool next(int i, Unit& o) const { if (i != 0) return false; o = u; return true; }
    __device__ __forceinline__ void a_ready(const Unit&) const {} __device__ __forceinline__ void done(const Unit&) const {} };

typedef float f32x2 __attribute__((ext_vector_type(2)));
typedef __bf16 bf16x2_t __attribute__((ext_vector_type(2)));
typedef _Float16 h2_t __attribute__((ext_vector_type(2)));
typedef unsigned u32x2 __attribute__((ext_vector_type(2)));
__device__ __forceinline__ unsigned pkbf(float lo, float hi) { f32x2 v = {lo, hi}; bf16x2_t b = __builtin_convertvector(v, bf16x2_t); return __builtin_bit_cast(unsigned, b); }
__device__ __forceinline__ unsigned pkh(float lo, float hi) { f32x2 v = {lo, hi}; h2_t b = __builtin_convertvector(v, h2_t); return __builtin_bit_cast(unsigned, b); }

__host__ __device__ __forceinline__ int inproj_src(int blk) {
    if (blk < 8) return 64 * blk;
    if (blk == 8) return 512;
    if (blk == 9) return 576;
    if (blk < 18) return 640 + 64 * (blk - 10);
    if (blk == 18) return 1152;
    if (blk < 27) return 1224 + 64 * (blk - 19);
    if (blk < 29) return 1736 + 64 * (blk - 27);
    if (blk < 31) return 1864 + 64 * (blk - 29);
    return 1216;
}

template <int ACT> struct EpiBf16 {
    static constexpr bool PERM = true, AFTER_DRAIN = false;
    bf16_t* O; int ldc; float scale;
    __device__ __forceinline__ void operator()(const f32x4 (&acc)[2][2][4][2], const Unit& u, int wr, int wc, int fr, int fq) const {
        const int row0 = u.pm * BM + wr * 64 + fr; const int col0 = u.pn * BM + wc * 32 + 8 * fq;
#pragma unroll
        for (int ai = 0; ai < 2; ++ai)
#pragma unroll
            for (int m = 0; m < 4; ++m) { bf16_t* rowp = O + (size_t)(row0 + ai * HALF + m * 16) * ldc + col0;
#pragma unroll
                for (int bj = 0; bj < 2; ++bj) { f32x4 v0 = acc[ai][bj][m][0], v1 = acc[ai][bj][m][1];
                    if (ACT == 2) {
#pragma unroll
                        for (int e = 0; e < 4; ++e) { float a = fmaxf(v0[e], 0.f), b = fmaxf(v1[e], 0.f); v0[e] = a * a; v1[e] = b * b; } }
                    v0 = v0 * scale; v1 = v1 * scale; u32x4 w; w.x = pkbf(v0[0], v0[1]); w.y = pkbf(v0[2], v0[3]); w.z = pkbf(v1[0], v1[1]); w.w = pkbf(v1[2], v1[3]);
                    *(u32x4*)(rowp + bj * HALF) = w; } }
    }
};

struct EpiMemKV {
    static constexpr bool PERM = true, AFTER_DRAIN = false;
    bf16_t* KF; bf16_t* O;
    __device__ __forceinline__ void operator()(const f32x4 (&acc)[2][2][4][2], const Unit& u, int wr, int wc, int fr, int fq) const {
        const int row0 = u.pm * BM + wr * 64 + fr; const int col0 = u.pn * BM + wc * 32 + 8 * fq;
#pragma unroll
        for (int ai = 0; ai < 2; ++ai)
#pragma unroll
            for (int m = 0; m < 4; ++m) { const int row = row0 + ai * HALF + m * 16;
#pragma unroll
                for (int bj = 0; bj < 2; ++bj) { const f32x4 v0 = acc[ai][bj][m][0], v1 = acc[ai][bj][m][1];
                    u32x4 w; w.x = pkbf(v0[0], v0[1]); w.y = pkbf(v0[2], v0[3]); w.z = pkbf(v1[0], v1[1]); w.w = pkbf(v1[2], v1[3]);
                    const int col = col0 + bj * HALF;
                    if (col < 1024) { const int b = row >> 8, key = row & 255, head = col >> 8, d = col & 255;
                        const size_t fo = ((size_t)((b * 4 + head) * 128 + (key >> 5) * 16 + (d >> 4)) * 64 + ((d >> 3) & 1) * 32 + (key & 31)) * 8;
                        *(u32x4*)(KF + fo) = w; }
                    else *(u32x4*)(O + (size_t)row * 2048 + col) = w; } }
    }
};

struct EpiInProj {
    static constexpr bool PERM = false, AFTER_DRAIN = false;
    const float* bias; const float* cosT; const float* sinT;
    bf16_t *dq, *dk, *dv, *sq, *sk, *sv; _Float16 *iq, *ik; float* iw;
    __device__ __forceinline__ void operator()(const f32x4 (&acc)[2][2][4][2], const Unit& u, int wr, int wc, int fr, int fq) const {
        const int g1 = wc & 1;
        const int dloc = 16 * g1 + 4 * fq;
#pragma unroll
        for (int bj = 0; bj < 2; ++bj) {
            const int blk = u.pn * 4 + bj * 2 + (wc >> 1);
            const int src = inproj_src(blk);
            const f32x4 b1 = *(const f32x4*)(bias + src + dloc), b2 = *(const f32x4*)(bias + src + 32 + dloc);
            unsigned short* dst; int ld, c0; bool rope = true, half16 = false;
            if (blk < 8) { dst = dq; ld = 512; c0 = blk * 64; }
            else if (blk == 8) { dst = dk; ld = 64; c0 = 0; }
            else if (blk == 9) { dst = dv; ld = 64; c0 = 0; rope = false; }
            else if (blk < 18) { dst = (unsigned short*)iq; ld = 512; c0 = (blk - 10) * 64; half16 = true; }
            else if (blk == 18) { dst = (unsigned short*)ik; ld = 64; c0 = 0; half16 = true; }
            else if (blk < 27) { dst = sq; ld = 512; c0 = (blk - 19) * 64; }
            else if (blk < 29) { dst = sk; ld = 128; c0 = (blk - 27) * 64; }
            else if (blk < 31) { dst = sv; ld = 128; c0 = (blk - 29) * 64; rope = false; }
            else { dst = nullptr; ld = 0; c0 = 0; rope = false; }
#pragma unroll
            for (int ai = 0; ai < 2; ++ai)
#pragma unroll
                for (int m = 0; m < 4; ++m) {
                    const int row = u.pm * BM + ai * HALF + wr * 64 + m * 16 + fr;
                    f32x4 x1 = acc[ai][bj][m][0] + b1, x2 = acc[ai][bj][m][1] + b2;
                    if (blk == 31) { if (g1 == 0 && fq < 2) *(f32x4*)(iw + (size_t)row * 8 + 4 * fq) = x1; continue; }
                    f32x4 o1 = x1, o2 = x2;
                    if (rope) { const f32x4 c = *(const f32x4*)(cosT + (size_t)row * 32 + dloc), s = *(const f32x4*)(sinT + (size_t)row * 32 + dloc);
                        o1 = x1 * c - x2 * s; o2 = x2 * c + x1 * s; }
                    u32x2 w1, w2;
                    if (half16) { w1.x = pkh(o1[0], o1[1]); w1.y = pkh(o1[2], o1[3]); w2.x = pkh(o2[0], o2[1]); w2.y = pkh(o2[2], o2[3]); }
                    else { w1.x = pkbf(o1[0], o1[1]); w1.y = pkbf(o1[2], o1[3]); w2.x = pkbf(o2[0], o2[1]); w2.y = pkbf(o2[2], o2[3]); }
                    if (blk == 18) {
                        const int t = row & 8191; const size_t fo = (size_t)(row >> 13) * (8192 * 64) + ((size_t)((t >> 5) * 4 + (dloc >> 4)) * 64 + ((dloc >> 3) & 1) * 32 + (t & 31)) * 8 + (dloc & 7);
                        *(u32x2*)(dst + fo) = w1; *(u32x2*)(dst + fo + 2 * 512) = w2; continue; }
                    unsigned short* p = dst + (size_t)row * ld + c0 + dloc;
                    *(u32x2*)p = w1; *(u32x2*)(p + 32) = w2;
                }
        }
    }
};

__device__ __forceinline__ f32x4 ld4(const float* p) { return *(const f32x4*)p; }
__device__ __forceinline__ f32x4 ld4(const bf16_t* p) { const u32x2 w = *(const u32x2*)p; return (f32x4){__uint_as_float(w.x << 16), __uint_as_float(w.x & 0xffff0000u), __uint_as_float(w.y << 16), __uint_as_float(w.y & 0xffff0000u)}; }
__device__ __forceinline__ void st4(float* p, f32x4 v) { *(f32x4*)p = v; }
__device__ __forceinline__ void st4(bf16_t* p, f32x4 v) { u32x2 w; w.x = pkbf(v[0], v[1]); w.y = pkbf(v[2], v[3]); *(u32x2*)p = w; }
__device__ __forceinline__ void ld8(const float* p, f32x4& a, f32x4& b) { a = *(const f32x4*)p; b = *(const f32x4*)(p + 4); }
__device__ __forceinline__ void ld8(const bf16_t* p, f32x4& a, f32x4& b) { const u32x4 w = *(const u32x4*)p;
    a = (f32x4){__uint_as_float(w.x << 16), __uint_as_float(w.x & 0xffff0000u), __uint_as_float(w.y << 16), __uint_as_float(w.y & 0xffff0000u)};
    b = (f32x4){__uint_as_float(w.z << 16), __uint_as_float(w.z & 0xffff0000u), __uint_as_float(w.w << 16), __uint_as_float(w.w & 0xffff0000u)}; }
__device__ __forceinline__ void st8(float* p, f32x4 a, f32x4 b) { *(f32x4*)p = a; *(f32x4*)(p + 4) = b; }
__device__ __forceinline__ void st8(bf16_t* p, f32x4 a, f32x4 b) { u32x4 w; w.x = pkbf(a[0], a[1]); w.y = pkbf(a[2], a[3]); w.z = pkbf(b[0], b[1]); w.w = pkbf(b[2], b[3]); *(u32x4*)p = w; }
template <bool LN, class TIN, class TOUT> struct EpiRes {
    static constexpr bool PERM = true, AFTER_DRAIN = false;
    const TIN* prev; TOUT* out; const f32x2* stats; const float* g; const float* b; float alpha;
    __device__ __forceinline__ void operator()(const f32x4 (&acc)[2][2][4][2], const Unit& u, int wr, int wc, int fr, int fq) const {
        const int col0 = u.pn * BM + wc * 32 + 8 * fq;
#pragma unroll
        for (int bj = 0; bj < 2; ++bj) {
            const int col = col0 + bj * HALF;
            f32x4 g0 = {1.f, 1.f, 1.f, 1.f}, g1 = g0, b0 = {0.f, 0.f, 0.f, 0.f}, b1 = b0;
            if (LN) { g0 = *(const f32x4*)(g + col); g1 = *(const f32x4*)(g + col + 4); b0 = *(const f32x4*)(b + col); b1 = *(const f32x4*)(b + col + 4); }
#pragma unroll
            for (int ai = 0; ai < 2; ++ai)
#pragma unroll
                for (int m = 0; m < 4; ++m) {
                    const int row = u.pm * BM + ai * HALF + wr * 64 + m * 16 + fr;
                    f32x2 st = {0.f, 1.f}; if (LN) st = stats[row];
                    const size_t off = (size_t)row * 1024 + col;
                    f32x4 r0, r1; ld8(prev + off, r0, r1);
                    if (LN) { r0 = (r0 - st.x) * st.y * g0 + b0; r1 = (r1 - st.x) * st.y * g1 + b1; }
                    st8(out + off, r0 * alpha + acc[ai][bj][m][0], r1 * alpha + acc[ai][bj][m][1]);
                }
        }
    }
};

template <class Epi, class Sched, bool ALIGN_EPI = false, bool SP2 = false>
__device__ __forceinline__ void gemm_phase(PG8_LAS unsigned char* lds, const Gemm g, const Sched& S, const Epi& E) {
    int tid_l = threadIdx.x; asm volatile("" : "+v"(tid_l));
    const int tid = tid_l, wid = __builtin_amdgcn_readfirstlane(tid >> 6), lane = tid & 63, wr = wid >> 2, wc = wid & 3, fr = lane & 15, fq = lane >> 4;
    const int K = g.K, nt = K / BK;
    unsigned voffA[2], voffB[2];
#pragma unroll
    for (int i = 0; i < 2; ++i) { int R, C; stage_rc(tid * 16 + i * 8192, R, C); const int Rb = Epi::PERM ? ((R & ~31) + perm32(R & 31)) : R;
        voffA[i] = (unsigned)(R * K + C) * 2u; voffB[i] = (unsigned)(Rb * K + C) * 2u; }
    const size_t kstep = (size_t)(BK * 2);
    const size_t hstep = (size_t)HALF * K * 2;
    const size_t tstep = 2 * hstep;
    const unsigned ldsw = (unsigned)wid * 1024u;
    const int aoff = lds_byte(wr * 64 + fr, fq * 8), boff = lds_byte(wc * 32 + fr, fq * 8);
#define PG8_SA(b, h) (((b) * 2 + (h)) * HTB)
#define PG8_SB(b, h) ((4 + (b) * 2 + (h)) * HTB)
#define PG8_STAGE(bufoff, gbase, voff) do { _Pragma("unroll") for (int _i = 0; _i < 2; ++_i) \
        __builtin_amdgcn_global_load_lds((const unsigned*)((const char*)(gbase) + (voff)[_i]), (PG8_LAS unsigned*)(lds + (bufoff) + ldsw + _i * 8192), 16, 0, 0); } while (0)
#define PG8_LDA(dst, b, h) do { _Pragma("unroll") for (int m = 0; m < 4; ++m) _Pragma("unroll") for (int k = 0; k < 2; ++k) dst[m][k] = *(const PG8_LAS bf16x8*)(lds + PG8_SA(b, h) + aoff + m * 2048 + k * 1024); } while (0)
#define PG8_LDB(dst, b, h) do { _Pragma("unroll") for (int n = 0; n < 2; ++n) _Pragma("unroll") for (int k = 0; k < 2; ++k) dst[n][k] = *(const PG8_LAS bf16x8*)(lds + PG8_SB(b, h) + boff + n * 2048 + k * 1024); } while (0)
#define PG8_MMA(ai, bj, At, Bt) do { __builtin_amdgcn_s_setprio(1); _Pragma("unroll") for (int m = 0; m < 4; ++m) _Pragma("unroll") for (int n = 0; n < 2; ++n) _Pragma("unroll") for (int k = 0; k < 2; ++k) \
        acc[ai][bj][m][n] = __builtin_amdgcn_mfma_f32_16x16x32_bf16(Bt[n][k], At[m][k], acc[ai][bj][m][n], 0, 0, 0); __builtin_amdgcn_s_setprio(0); } while (0)
#define PG8_WAIT_V(n) asm volatile("s_waitcnt vmcnt(" #n ")" ::: "memory")
#define PG8_WAIT_L(n) asm volatile("s_waitcnt lgkmcnt(" #n ")" ::: "memory")
#define PG8_BAR __builtin_amdgcn_s_barrier()
#define PG8_SCHED __builtin_amdgcn_sched_barrier(0)
    Unit cur, nxt; int ui = 0;
    if (!S.next(0, cur)) return;
    f32x4 acc[2][2][4][2];
#pragma unroll
    for (int a = 0; a < 2; ++a)
#pragma unroll
        for (int b = 0; b < 2; ++b)
#pragma unroll
            for (int m = 0; m < 4; ++m)
#pragma unroll
                for (int n = 0; n < 2; ++n) acc[a][b][m][n] = (f32x4){0.f, 0.f, 0.f, 0.f};
    bf16x8 At[4][2], B0[2][2], B1[2][2];
    const char* cA = (const char*)g.A + (size_t)cur.pm * tstep; const char* cB = (const char*)g.Bt + (size_t)cur.pn * tstep;
    S.a_ready(cur);
    if constexpr (SP2) {
        PG8_STAGE(PG8_SB(0, 0), cB, voffB); PG8_STAGE(PG8_SB(0, 1), cB + hstep, voffB); PG8_STAGE(PG8_SA(0, 0), cA, voffA); PG8_STAGE(PG8_SA(0, 1), cA + hstep, voffA);
        if (wr == 1) PG8_BAR;
        PG8_WAIT_V(2); PG8_BAR;
        PG8_STAGE(PG8_SB(1, 0), cB + kstep, voffB); PG8_STAGE(PG8_SA(1, 0), cA + kstep, voffA); PG8_STAGE(PG8_SB(1, 1), cB + hstep + kstep, voffB);
        PG8_WAIT_V(6); PG8_BAR;
    } else {
        PG8_STAGE(PG8_SB(0, 0), cB, voffB); PG8_STAGE(PG8_SA(0, 0), cA, voffA); PG8_STAGE(PG8_SB(0, 1), cB + hstep, voffB); PG8_STAGE(PG8_SA(0, 1), cA + hstep, voffA);
        if (wr == 1) PG8_BAR;
        PG8_WAIT_V(4); PG8_BAR;
        PG8_STAGE(PG8_SB(1, 0), cB + kstep, voffB); PG8_STAGE(PG8_SA(1, 0), cA + kstep, voffA); PG8_STAGE(PG8_SB(1, 1), cB + hstep + kstep, voffB);
        PG8_WAIT_V(6); PG8_BAR;
    }
    for (;;) {
        const bool has_next = S.next(ui + 1, nxt);
        const char* nA = has_next ? (const char*)g.A + (size_t)nxt.pm * tstep : cA; const char* nB = has_next ? (const char*)g.Bt + (size_t)nxt.pn * tstep : cB;
        for (int t = 0; t < nt; t += 2) {
            const bool last = (t == nt - 2);
            const char* a1 = cA + (size_t)(t + 1) * kstep;
            const char* a2 = last ? nA : cA + (size_t)(t + 2) * kstep; const char* b2 = last ? nB : cB + (size_t)(t + 2) * kstep;
            const char* a3 = a2 + kstep; const char* b3 = b2 + kstep;
            if (last && has_next) S.a_ready(nxt);
            if constexpr (SP2) {
            PG8_LDB(B0, 0, 0); PG8_LDB(B1, 0, 1); PG8_SCHED; PG8_LDA(At, 0, 0); PG8_STAGE(PG8_SA(1, 1), a1 + hstep, voffA);
            PG8_WAIT_V(8); PG8_WAIT_L(0); PG8_BAR; PG8_MMA(0, 0, At, B0); PG8_MMA(0, 1, At, B1); PG8_BAR; PG8_SCHED;
            PG8_LDA(At, 0, 1); PG8_STAGE(PG8_SB(0, 0), b2, voffB); PG8_STAGE(PG8_SB(0, 1), b2 + hstep, voffB); PG8_STAGE(PG8_SA(0, 0), a2, voffA);
            PG8_WAIT_V(8); PG8_WAIT_L(0); PG8_BAR; PG8_MMA(1, 0, At, B0); PG8_MMA(1, 1, At, B1); PG8_BAR; PG8_SCHED;
            PG8_LDB(B0, 1, 0); PG8_LDB(B1, 1, 1); PG8_SCHED; PG8_LDA(At, 1, 0); PG8_STAGE(PG8_SA(0, 1), a2 + hstep, voffA);
            PG8_WAIT_V(8); PG8_WAIT_L(0); PG8_BAR; PG8_MMA(0, 0, At, B0); PG8_MMA(0, 1, At, B1); PG8_BAR; PG8_SCHED;
            PG8_LDA(At, 1, 1); PG8_STAGE(PG8_SB(1, 0), b3, voffB); PG8_STAGE(PG8_SB(1, 1), b3 + hstep, voffB); PG8_STAGE(PG8_SA(1, 0), a3, voffA);
            PG8_WAIT_V(8); PG8_WAIT_L(0); PG8_BAR; PG8_MMA(1, 0, At, B0); PG8_MMA(1, 1, At, B1); PG8_BAR; PG8_SCHED;
            } else {
            PG8_LDB(B0, 0, 0); PG8_SCHED; PG8_LDA(At, 0, 0); PG8_STAGE(PG8_SA(1, 1), a1 + hstep, voffA);
            PG8_WAIT_L(8); PG8_BAR; PG8_WAIT_L(0); PG8_MMA(0, 0, At, B0); PG8_BAR; PG8_SCHED;
            PG8_LDB(B1, 0, 1); PG8_STAGE(PG8_SB(0, 0), b2, voffB);
            PG8_BAR; PG8_WAIT_L(0); PG8_MMA(0, 1, At, B1); PG8_BAR;
            PG8_LDA(At, 0, 1); PG8_STAGE(PG8_SA(0, 0), a2, voffA);
            PG8_BAR; PG8_WAIT_L(0); PG8_MMA(1, 0, At, B0); PG8_BAR; PG8_SCHED;
            PG8_STAGE(PG8_SB(0, 1), b2 + hstep, voffB);
            PG8_WAIT_V(6); PG8_BAR; PG8_MMA(1, 1, At, B1); PG8_BAR;
            PG8_LDB(B0, 1, 0); PG8_SCHED; PG8_LDA(At, 1, 0); PG8_STAGE(PG8_SA(0, 1), a2 + hstep, voffA);
            PG8_WAIT_L(8); PG8_BAR; PG8_WAIT_L(0); PG8_MMA(0, 0, At, B0); PG8_BAR; PG8_SCHED;
            PG8_LDB(B1, 1, 1); PG8_STAGE(PG8_SB(1, 0), b3, voffB);
            PG8_BAR; PG8_WAIT_L(0); PG8_MMA(0, 1, At, B1); PG8_BAR;
            PG8_LDA(At, 1, 1); PG8_STAGE(PG8_SA(1, 0), a3, voffA);
            PG8_BAR; PG8_WAIT_L(0); PG8_MMA(1, 0, At, B0); PG8_BAR; PG8_SCHED;
            PG8_STAGE(PG8_SB(1, 1), b3 + hstep, voffB);
            PG8_WAIT_V(6); PG8_BAR; PG8_MMA(1, 1, At, B1); PG8_BAR;
            }
        }
        if constexpr (ALIGN_EPI) { if (wr == 0) PG8_BAR; }
        if constexpr (!Epi::AFTER_DRAIN) { E(acc, cur, wr, wc, fr, fq); S.done(cur); }
        if (!has_next) break;
#pragma unroll
        for (int a = 0; a < 2; ++a)
#pragma unroll
            for (int b = 0; b < 2; ++b)
#pragma unroll
                for (int m = 0; m < 4; ++m)
#pragma unroll
                    for (int n = 0; n < 2; ++n) acc[a][b][m][n] = (f32x4){0.f, 0.f, 0.f, 0.f};
        cur = nxt; cA = nA; cB = nB; ++ui;
        if constexpr (ALIGN_EPI) { if (wr == 1) PG8_BAR; }
    }
    PG8_WAIT_V(0);
    if constexpr (!ALIGN_EPI) { if (wr == 0) PG8_BAR; }
    PG8_BAR;
    if constexpr (Epi::AFTER_DRAIN) { E.fused(acc, cur, wr, wc, fr, fq, lds, wid, lane); S.done(cur); }
#undef PG8_SA
#undef PG8_SB
#undef PG8_STAGE
#undef PG8_LDA
#undef PG8_LDB
#undef PG8_MMA
#undef PG8_WAIT_V
#undef PG8_WAIT_L
#undef PG8_BAR
#undef PG8_SCHED
}
}
#define LAS __attribute__((address_space(3)))
typedef unsigned short bf16;
typedef short bf16x8 __attribute__((ext_vector_type(8)));
typedef _Float16 f16x8 __attribute__((ext_vector_type(8)));
typedef float f32x4 __attribute__((ext_vector_type(4)));
typedef float f32x16 __attribute__((ext_vector_type(16)));
typedef float f32x2 __attribute__((ext_vector_type(2)));
typedef unsigned u32x4 __attribute__((ext_vector_type(4)));
typedef unsigned u32x2 __attribute__((ext_vector_type(2)));
typedef short v4i16_t __attribute__((ext_vector_type(4)));
using pg8::pkbf;

constexpr int NB = 4, SEQ = 8192, DM = 1024, MTOK = NB * SEQ, NPROJ = 2048, FF = 4096, MEMT = 256, MROWS = NB * MEMT;
constexpr float LN_EPS = 1e-5f;
constexpr float ALPHA = 1.189207115002721f;
constexpr float LOG2E = 1.4426950408889634f;
constexpr int NWAVES = 8, NTHR = 512;
constexpr int LDS_BYTES = 163840;
constexpr int MISC_OFF = 163328;

constexpr size_t MiB = 1u << 20;
constexpr size_t WS_WIN = 1 * MiB, WS_WO = 5 * MiB, WS_WQ = 7 * MiB, WS_WKV = 9 * MiB, WS_WOM = 13 * MiB, WS_WUP = 15 * MiB, WS_WDN = 23 * MiB;
constexpr size_t WS_MEMB = 31 * MiB, WS_MEMKV = 33 * MiB, WS_COS = 37 * MiB, WS_SIN = 41 * MiB, WS_ST1 = 45 * MiB, WS_ST2 = 46 * MiB;
constexpr size_t WS_MEMKF = 496 * MiB;
constexpr size_t WS_RA = 48 * MiB;
constexpr size_t WS_RB = 112 * MiB;
constexpr size_t WS_DQ = WS_RB, WS_SQ = WS_RB + 32 * MiB, WS_IQ = WS_RB + 64 * MiB, WS_DK = WS_RB + 96 * MiB, WS_DV = WS_RB + 100 * MiB, WS_IK = WS_RB + 104 * MiB,
                 WS_SK = WS_RB + 108 * MiB, WS_SV = WS_RB + 116 * MiB, WS_IW = WS_RB + 124 * MiB;
constexpr size_t WS_RC = 240 * MiB;
constexpr size_t WS_RD = 368 * MiB;
constexpr size_t WS_RE = 432 * MiB;
constexpr size_t WS_END = 498 * MiB;

__device__ __forceinline__ int crow(int reg, int hi) { return (reg & 3) + 8 * (reg >> 2) + 4 * hi; }
__device__ __forceinline__ float wave_sum(float v) {
#pragma unroll
    for (int o = 1; o < 64; o <<= 1) v += __shfl_xor(v, o);
    return v;
}
__device__ __forceinline__ v4i16_t trrd(LAS unsigned char* p) { return __builtin_amdgcn_ds_read_tr16_b64_v4i16((LAS v4i16_t*)p); }
#define MFMA32BF(a, b, c) __builtin_amdgcn_mfma_f32_32x32x16_bf16((a), (b), (c), 0, 0, 0)
#define MFMA16BF(a, b, c) __builtin_amdgcn_mfma_f32_16x16x32_bf16((a), (b), (c), 0, 0, 0)
#define MFMA32H(a, b, c) __builtin_amdgcn_mfma_f32_32x32x16_f16((a), (b), (c), 0, 0, 0)

struct Params {
    const float* x; const float* mem; const int* pos; const float* w_in; const float* b_in; const float* sinks; const float* w_o;
    const float* ln1g; const float* ln1b; const float* wq; const float* wk; const float* wv; const float* wom; const float* ln2g; const float* ln2b;
    const float* wup; const float* wdn; const float* ln3g; const float* ln3b;
    float* out; unsigned char* ws;
};

__device__ __forceinline__ void transpose_item(const float* W, int K, int N, bf16* WT, int row_off, int nblk, int mode, LAS float* scr, int item, int lane) {
    const int kb = item / nblk, nb = item % nblk, k0 = 64 * kb, n0 = 32 * nb;
    const int nl = lane & 31;
    int src = n0 + nl;
    if (mode == 1) { const int blk = nb >> 1, g1 = nb & 1, n = nl >> 4, i = nl & 15, d = 32 * n + 16 * g1 + i; src = pg8::inproj_src(blk) + d; if (blk == 31 && d >= 8) src = -1; }
#pragma unroll 8
    for (int i = 0; i < 32; ++i) { const int kk = 2 * i + (lane >> 5); scr[kk * 33 + nl] = (src >= 0) ? W[(size_t)(k0 + kk) * N + src] : 0.f; }
    asm volatile("s_waitcnt lgkmcnt(0)" ::: "memory");
    const int c = lane & 7;
#pragma unroll
    for (int j = 0; j < 4; ++j) { const int n = (lane >> 3) + 8 * j; const LAS float* s = scr + (8 * c) * 33 + n;
        u32x4 o; o.x = pkbf(s[0 * 33], s[1 * 33]); o.y = pkbf(s[2 * 33], s[3 * 33]); o.z = pkbf(s[4 * 33], s[5 * 33]); o.w = pkbf(s[6 * 33], s[7 * 33]);
        *(u32x4*)(WT + (size_t)(row_off + n0 + n) * K + k0 + 8 * c) = o; }
    asm volatile("s_waitcnt lgkmcnt(0)" ::: "memory");
}

__device__ __forceinline__ void p0_prologue(const Params& P, LAS unsigned char* lds, int bid, int G, int tid, int wid, int lane) {
    asm volatile("" : "+v"(lane), "+v"(tid));
    unsigned char* ws = P.ws;
    LAS float* scr = (LAS float*)(lds + wid * 16384);
    const int gw = bid * NWAVES + wid, NGW = G * NWAVES;
    constexpr int I_IN = 16 * 64, I_SQ = 16 * 32, I_UP = 16 * 128, I_DN = 64 * 32;
    constexpr int NITEMS = I_IN + 5 * I_SQ + I_UP + I_DN;
    for (int it = gw; it < NITEMS; it += NGW) {
        int r = it;
        if (r < I_IN) { transpose_item(P.w_in, DM, 1992, (bf16*)(ws + WS_WIN), 0, 64, 1, scr, r, lane); continue; } r -= I_IN;
        if (r < I_SQ) { transpose_item(P.w_o, DM, DM, (bf16*)(ws + WS_WO), 0, 32, 0, scr, r, lane); continue; } r -= I_SQ;
        if (r < I_SQ) { transpose_item(P.wq, DM, DM, (bf16*)(ws + WS_WQ), 0, 32, 0, scr, r, lane); continue; } r -= I_SQ;
        if (r < I_SQ) { transpose_item(P.wk, DM, DM, (bf16*)(ws + WS_WKV), 0, 32, 0, scr, r, lane); continue; } r -= I_SQ;
        if (r < I_SQ) { transpose_item(P.wv, DM, DM, (bf16*)(ws + WS_WKV), 1024, 32, 0, scr, r, lane); continue; } r -= I_SQ;
        if (r < I_SQ) { transpose_item(P.wom, DM, DM, (bf16*)(ws + WS_WOM), 0, 32, 0, scr, r, lane); continue; } r -= I_SQ;
        if (r < I_UP) { transpose_item(P.wup, DM, FF, (bf16*)(ws + WS_WUP), 0, 128, 0, scr, r, lane); continue; } r -= I_UP;
        transpose_item(P.wdn, FF, DM, (bf16*)(ws + WS_WDN), 0, 32, 0, scr, r, lane);
    }
    const int gt = bid * NTHR + tid, NGT = G * NTHR;
    { bf16* xb = (bf16*)(ws + WS_RA);
      for (int i = gw; i < MTOK * DM / 512; i += NGW) { const size_t base = (size_t)i * 512 + 4 * lane;
          const f32x4 a = *(const f32x4*)(P.x + base), b = *(const f32x4*)(P.x + base + 256);
          u32x2 oa, ob; oa.x = pkbf(a[0], a[1]); oa.y = pkbf(a[2], a[3]); ob.x = pkbf(b[0], b[1]); ob.y = pkbf(b[2], b[3]);
          *(u32x2*)(xb + base) = oa; *(u32x2*)(xb + base + 256) = ob; }
      bf16* mb = (bf16*)(ws + WS_MEMB);
      for (int i = gw; i < MROWS * DM / 512; i += NGW) { const size_t base = (size_t)i * 512 + 4 * lane;
          const f32x4 a = *(const f32x4*)(P.mem + base), b = *(const f32x4*)(P.mem + base + 256);
          u32x2 oa, ob; oa.x = pkbf(a[0], a[1]); oa.y = pkbf(a[2], a[3]); ob.x = pkbf(b[0], b[1]); ob.y = pkbf(b[2], b[3]);
          *(u32x2*)(mb + base) = oa; *(u32x2*)(mb + base + 256) = ob; } }
    { float* cT = (float*)(ws + WS_COS); float* sT = (float*)(ws + WS_SIN);
      for (int i = gt; i < MTOK * 32; i += NGT) { const int tok = i >> 5, k = i & 31;
          const double inv = exp2(-(double)k * (13.287712379549449 / 32.0));
          const double ang = (double)P.pos[tok] * inv;
          const double r = ang - 6.283185307179586476925 * rint(ang * 0.15915494309189533577);
          const float rf = (float)r; cT[i] = cosf(rf); sT[i] = sinf(rf); } }
}

template <class TIN> __device__ __forceinline__ void ln_pass(const TIN* y, const float* g, const float* b, bf16* hb, f32x2* stats, float* outf, int gw, int NGW, int lane) {
    asm volatile("" : "+v"(lane));
    f32x4 gv[4], bv[4];
#pragma unroll
    for (int j = 0; j < 4; ++j) { gv[j] = *(const f32x4*)(g + 4 * lane + 256 * j); bv[j] = *(const f32x4*)(b + 4 * lane + 256 * j); }
    for (int m = gw; m < MTOK; m += NGW) {
        f32x4 v[4]; float s = 0.f;
#pragma unroll
        for (int j = 0; j < 4; ++j) { v[j] = pg8::ld4(y + (size_t)m * DM + 4 * lane + 256 * j); s += (v[j][0] + v[j][1]) + (v[j][2] + v[j][3]); }
        const float mean = wave_sum(s) * (1.f / DM); float s2 = 0.f;
#pragma unroll
        for (int j = 0; j < 4; ++j) { v[j] = v[j] - mean; s2 += (v[j][0] * v[j][0] + v[j][1] * v[j][1]) + (v[j][2] * v[j][2] + v[j][3] * v[j][3]); }
        const float rstd = 1.f / sqrtf(wave_sum(s2) * (1.f / DM) + LN_EPS);
        if (stats && lane == 0) stats[m] = (f32x2){mean, rstd};
#pragma unroll
        for (int j = 0; j < 4; ++j) { const f32x4 o = v[j] * rstd * gv[j] + bv[j];
            if (hb) { u32x2 w; w.x = pkbf(o[0], o[1]); w.y = pkbf(o[2], o[3]); *((u32x2*)(hb + (size_t)m * DM) + lane + 64 * j) = w; }
            if (outf) *((f32x4*)(outf + (size_t)m * DM) + lane + 64 * j) = o; }
    }
}

__device__ __forceinline__ unsigned okey(float f) { unsigned u = __float_as_uint(f); if ((u << 1) == 0u) u = 0u; return u ^ (((unsigned)((int)u >> 31)) | 0x80000000u); }
constexpr int DSA_C = 808;
constexpr int DSA_WREG = 20416;
constexpr int DSA_QB = 4848, DSA_IOFF = 3232;
constexpr int DSA_NE = 13;
#ifndef DSA_RD
#define DSA_RD 3
#endif

#define DPPI(v, ctrl) ((unsigned)__builtin_amdgcn_update_dpp((int)(v), (int)(v), (ctrl), 0xF, 0xF, false))
__device__ __forceinline__ unsigned wave_and(unsigned v) {
    v &= DPPI(v, 0xB1); v &= DPPI(v, 0x4E); v &= DPPI(v, 0x141); v &= DPPI(v, 0x140);
    return (unsigned)__builtin_amdgcn_readlane((int)v, 0) & (unsigned)__builtin_amdgcn_readlane((int)v, 16) & (unsigned)__builtin_amdgcn_readlane((int)v, 32) & (unsigned)__builtin_amdgcn_readlane((int)v, 48); }
__device__ __forceinline__ unsigned wave_or(unsigned v) {
    v |= DPPI(v, 0xB1); v |= DPPI(v, 0x4E); v |= DPPI(v, 0x141); v |= DPPI(v, 0x140);
    return (unsigned)__builtin_amdgcn_readlane((int)v, 0) | (unsigned)__builtin_amdgcn_readlane((int)v, 16) | (unsigned)__builtin_amdgcn_readlane((int)v, 32) | (unsigned)__builtin_amdgcn_readlane((int)v, 48); }

constexpr unsigned DSA_KEEP = 384u;
template <bool EXACT>
__device__ __forceinline__ unsigned dsa_compact(LAS unsigned char* qreg, LAS unsigned* hist, int cnt, int lane, int& newcnt) {
    __builtin_amdgcn_s_setprio(2);
    LAS unsigned* kb = (LAS unsigned*)qreg; LAS unsigned short* ib = (LAS unsigned short*)(qreg + DSA_IOFF);
    unsigned ek[DSA_NE]; unsigned short ei[DSA_NE];
#pragma unroll
    for (int i = 0; i < DSA_NE; ++i) { const int e = i * 64 + lane; const unsigned kv = kb[e]; ei[i] = ib[e]; ek[i] = (e < cnt) ? kv : 0u; }
    unsigned av = 0xFFFFFFFFu, ov = 0u;
#pragma unroll
    for (int i = 0; i < DSA_NE; ++i) { av &= (i * 64 + lane < cnt) ? ek[i] : 0xFFFFFFFFu; ov |= ek[i]; }
    av = wave_and(av); ov = wave_or(ov);
    const unsigned diff = av ^ ov;
    int sprev = diff ? (32 - __builtin_clz(diff)) : 0;
    unsigned prefix = (sprev < 32) ? ((ov >> sprev) << sprev) : 0u;
    unsigned krem = 256u; unsigned kept = (unsigned)cnt;
#pragma unroll 1
    while (sprev > 0 && (EXACT || kept > DSA_KEEP)) {
        const int s = sprev > 8 ? sprev - 8 : 0;
        const unsigned mask = (sprev < 32) ? (0xFFFFFFFFu << sprev) : 0u;
        *(LAS u32x4*)(hist + 4 * lane) = (u32x4){0u, 0u, 0u, 0u};
#pragma unroll
        for (int i = 0; i < DSA_NE; ++i) { if ((i * 64 + lane < cnt) && ((ek[i] & mask) == prefix)) __hip_atomic_fetch_add(hist + ((ek[i] >> s) & 255u), 1u, __ATOMIC_RELAXED, __HIP_MEMORY_SCOPE_WORKGROUP); }
        asm volatile("s_waitcnt lgkmcnt(0)" ::: "memory");
        const u32x4 hv = *(const LAS u32x4*)(hist + 4 * lane);
        const unsigned tot = hv.x + hv.y + hv.z + hv.w;
        unsigned suf = tot;
        suf += (unsigned)__builtin_amdgcn_update_dpp(0, (int)suf, 0x101, 0xF, 0xF, true);
        suf += (unsigned)__builtin_amdgcn_update_dpp(0, (int)suf, 0x102, 0xF, 0xF, true);
        suf += (unsigned)__builtin_amdgcn_update_dpp(0, (int)suf, 0x104, 0xF, 0xF, true);
        suf += (unsigned)__builtin_amdgcn_update_dpp(0, (int)suf, 0x108, 0xF, 0xF, true);
        { const unsigned r1 = (unsigned)__builtin_amdgcn_readlane((int)suf, 16), r2 = (unsigned)__builtin_amdgcn_readlane((int)suf, 32), r3 = (unsigned)__builtin_amdgcn_readlane((int)suf, 48);
          const int row = lane >> 4; suf += row == 0 ? (r1 + r2 + r3) : row == 1 ? (r2 + r3) : row == 2 ? r3 : 0u; }
        const unsigned c3 = suf - tot, c2 = c3 + hv.w, c1 = c2 + hv.z, c0 = c1 + hv.y;
        int sel = -1; unsigned cg_ = 0u, hc_ = 0u;
        if (c3 < krem && krem <= c3 + hv.w) { sel = 3; cg_ = c3; hc_ = hv.w; }
        else if (c2 < krem && krem <= c2 + hv.z) { sel = 2; cg_ = c2; hc_ = hv.z; }
        else if (c1 < krem && krem <= c1 + hv.y) { sel = 1; cg_ = c1; hc_ = hv.y; }
        else if (c0 < krem && krem <= c0 + hv.x) { sel = 0; cg_ = c0; hc_ = hv.x; }
        const unsigned long long bal = __ballot(sel >= 0);
        const int srcl = bal ? (int)__builtin_ctzll(bal) : 0;
        const unsigned dbin = (unsigned)__builtin_amdgcn_readlane(4 * lane + (sel >= 0 ? sel : 0), srcl);
        const unsigned cgt = (unsigned)__builtin_amdgcn_readlane((int)cg_, srcl);
        const unsigned hcn = (unsigned)__builtin_amdgcn_readlane((int)hc_, srcl);
        prefix |= dbin << s; krem -= cgt; sprev = s;
        kept = 256u - krem + hcn;
    }
    unsigned T = prefix;
    if (!EXACT && sprev > 0) { T = prefix - 1u; krem = 0u; newcnt = (int)kept; } else { newcnt = 256; }
    unsigned run = 0u, eqrun = 0u;
    LAS unsigned* dK = hist + lane; LAS unsigned short* dI = (LAS unsigned short*)(hist + 128) + lane;
#pragma unroll
    for (int i = 0; i < DSA_NE; ++i) {
        const unsigned key = ek[i];
        bool take = key > T;
        if (EXACT) { const bool eq = key == T; const unsigned long long eqm = __ballot(eq);
            const unsigned eqrank = eqrun + __builtin_amdgcn_mbcnt_hi((unsigned)(eqm >> 32), __builtin_amdgcn_mbcnt_lo((unsigned)eqm, 0u));
            take = take || (eq && eqrank < krem); eqrun += (unsigned)__builtin_popcountll(eqm); }
        const unsigned long long tm = __ballot(take);
        const unsigned pos = run + __builtin_amdgcn_mbcnt_hi((unsigned)(tm >> 32), __builtin_amdgcn_mbcnt_lo((unsigned)tm, 0u));
        LAS unsigned* pk = take ? (kb + pos) : dK; LAS unsigned short* pi = take ? (ib + pos) : dI;
        *pk = key; *pi = ei[i];
        run += (unsigned)__builtin_popcountll(tm);
    }
    asm volatile("s_waitcnt lgkmcnt(0)" ::: "memory");
    __builtin_amdgcn_s_setprio(0);
    return T;
}

__device__ __forceinline__ void dsa_phase(LAS unsigned char* lds, const _Float16* iq, const _Float16* ik, const float* iw, const bf16* dq, const bf16* dk, const bf16* dv,
                                          bf16* attn, int bid, int G, int tid, int wid, int lane) {
    asm volatile("" : "+v"(lane));
    LAS unsigned char* W = lds + wid * DSA_WREG;
    LAS unsigned* hist = (LAS unsigned*)W;
    const int r32 = lane & 31, hi = lane >> 5;
    constexpr int NT = NB * (SEQ / 32);
#pragma unroll 1
    for (int jj = 0; jj * G < NT; ++jj) {
        const int tidx = jj * G + ((jj & 1) ? (G - 1 - bid) : bid);
        if (tidx >= NT) continue;
        const int b = tidx / (SEQ / 32), qt = tidx % (SEQ / 32), t0 = 32 * qt, tw = t0 + 4 * wid;
        const size_t tokb = (size_t)b * SEQ;
        int cnt0 = 0, cnt1 = 0, cnt2 = 0, cnt3 = 0;
        {
            const int a = r32 >> 3, hr = (r32 >> 2) & 1, j4 = r32 & 3;
            const int rq = 2 * (a & 1) + hr, rh = 4 * (a >> 1) + j4;
            const _Float16* qp = iq + (tokb + tw + rq) * 512 + rh * 64 + 8 * hi;
            f16x8 qa[4];
#pragma unroll
            for (int s = 0; s < 4; ++s) qa[s] = *(const f16x8*)(qp + 16 * s);
            f16x8 w2[2];
            { const int qrow = (r32 == 0) ? 0 : (r32 == 1) ? 1 : (r32 == 4) ? 2 : (r32 == 5) ? 3 : -1;
              const f32x4 wa = *(const f32x4*)(iw + (tokb + tw + (qrow < 0 ? 0 : qrow)) * 8), wb = *(const f32x4*)(iw + (tokb + tw + (qrow < 0 ? 0 : qrow)) * 8 + 4);
#pragma unroll
              for (int s2 = 0; s2 < 2; ++s2)
#pragma unroll
                for (int j = 0; j < 8; ++j) { const float wv = s2 == 0 ? wa[j & 3] : wb[j & 3]; w2[s2][j] = (_Float16)((qrow == 2 * (j >> 2) + hi) ? wv : 0.f); } }
            LAS unsigned* kbA = (LAS unsigned*)(W + 1024 + DSA_QB * (2 * hi)); LAS unsigned short* ibA = (LAS unsigned short*)(W + 1024 + DSA_QB * (2 * hi) + DSA_IOFF);
            LAS unsigned* kbB = (LAS unsigned*)(W + 1024 + DSA_QB * (2 * hi + 1)); LAS unsigned short* ibB = (LAS unsigned short*)(W + 1024 + DSA_QB * (2 * hi + 1) + DSA_IOFF);
            LAS unsigned* dumpK = hist + lane; LAS unsigned short* dumpI = (LAS unsigned short*)(hist + 128) + lane;
            unsigned tauA = 0u, tauB = 0u;
            int cntA = 0, cntB = 0;
            const int tmaxA = tw + 2 * hi, tmaxB = tw + 2 * hi + 1;
            const int nch = qt + 1;
            const _Float16* kp = ik + tokb * 64 + lane * 8;
            f16x8 kr[DSA_RD][4];
#pragma unroll
            for (int u = 0; u < DSA_RD; ++u) { const int cl = u < nch ? u : nch - 1;
#pragma unroll
                for (int s = 0; s < 4; ++s) kr[u][s] = *(const f16x8*)(kp + (size_t)cl * 2048 + 512 * s); }
#pragma unroll 1
            for (int c = 0; c < nch; c += DSA_RD) {
                cnt0 = __builtin_amdgcn_readlane(cntA, 0); cnt1 = __builtin_amdgcn_readlane(cntB, 0); cnt2 = __builtin_amdgcn_readlane(cntA, 32); cnt3 = __builtin_amdgcn_readlane(cntB, 32);
#pragma unroll 1
                for (int q = 0; q < 4; ++q) { const int cq = q == 0 ? cnt0 : q == 1 ? cnt1 : q == 2 ? cnt2 : cnt3;
                    if (cq > DSA_C - 32 * DSA_RD) { int nc; const unsigned T = dsa_compact<false>(W + 1024 + q * DSA_QB, hist, cq, lane, nc);
                        if ((q >> 1) == hi) { if ((q & 1) == 0) { tauA = T; cntA = nc; } else { tauB = T; cntB = nc; } } } }
                f32x16 Cc = {};
#pragma unroll
                for (int s = 0; s < 4; ++s) Cc = MFMA32H(qa[s], kr[0][s], Cc);
                f32x16 Yp = {};
#pragma unroll
                for (int u = 0; u <= DSA_RD; ++u) {
                    f32x16 Cn = {};
                    if (u + 1 < DSA_RD) {
#pragma unroll
                        for (int s = 0; s < 4; ++s) Cn = MFMA32H(qa[s], kr[u + 1][s], Cn);
                    }
                    f32x16 Y = {};
                    if (u < DSA_RD) {
                        { const int cn = (c + u + DSA_RD < nch) ? (c + u + DSA_RD) : (nch - 1);
#pragma unroll
                            for (int s = 0; s < 4; ++s) kr[u][s] = *(const f16x8*)(kp + (size_t)cn * 2048 + 512 * s); }
                        f16x8 xf[2];
#pragma unroll
                        for (int s2 = 0; s2 < 2; ++s2)
#pragma unroll
                            for (int j = 0; j < 8; j += 2) { pg8::h2_t hv = __builtin_convertvector((f32x2){Cc[8 * s2 + j], Cc[8 * s2 + j + 1]}, pg8::h2_t);
                                hv = __builtin_elementwise_max(hv, (pg8::h2_t){(_Float16)0.f, (_Float16)0.f}); xf[s2][j] = hv[0]; xf[s2][j + 1] = hv[1]; }
                        Y = MFMA32H(w2[0], xf[0], Y); Y = MFMA32H(w2[1], xf[1], Y);
                    }
                    __builtin_amdgcn_sched_barrier(0);
                    if (u > 0) {
                        const float s0 = Yp[0], s1 = Yp[1];
                        const int kidx = 32 * (c + u - 1) + r32;
                        const unsigned k0 = (kidx <= tmaxA) ? okey(s0) : 0u, k1 = (kidx <= tmaxB) ? okey(s1) : 0u;
                        const bool p0 = k0 > tauA, p1 = k1 > tauB;
                        const unsigned long long b0 = __ballot(p0), b1 = __ballot(p1);
                        const unsigned lo0 = (unsigned)b0, hi0 = (unsigned)(b0 >> 32), lo1 = (unsigned)b1, hi1 = (unsigned)(b1 >> 32);
                        const int pos0 = cntA + (int)__builtin_amdgcn_mbcnt_hi(hi0, __builtin_amdgcn_mbcnt_lo(hi ? 0u : lo0, 0u));
                        const int pos1 = cntB + (int)__builtin_amdgcn_mbcnt_hi(hi1, __builtin_amdgcn_mbcnt_lo(hi ? 0u : lo1, 0u));
                        LAS unsigned* ka = p0 ? (kbA + pos0) : dumpK; LAS unsigned short* ia = p0 ? (ibA + pos0) : dumpI;
                        LAS unsigned* kb_ = p1 ? (kbB + pos1) : dumpK; LAS unsigned short* ib_ = p1 ? (ibB + pos1) : dumpI;
                        *ka = k0; *ia = (unsigned short)kidx; *kb_ = k1; *ib_ = (unsigned short)kidx;
                        cntA += __builtin_popcount(hi ? hi0 : lo0); cntB += __builtin_popcount(hi ? hi1 : lo1);
                    }
                    __builtin_amdgcn_sched_barrier(0);
                    Cc = Cn; Yp = Y;
                }
            }
            asm volatile("s_waitcnt lgkmcnt(0)" ::: "memory");
            cnt0 = __builtin_amdgcn_readlane(cntA, 0); cnt1 = __builtin_amdgcn_readlane(cntB, 0); cnt2 = __builtin_amdgcn_readlane(cntA, 32); cnt3 = __builtin_amdgcn_readlane(cntB, 32);
#pragma unroll 1
            for (int q = 0; q < 4; ++q) { const int cq = q == 0 ? cnt0 : q == 1 ? cnt1 : q == 2 ? cnt2 : cnt3;
                if (cq > 256) { int nc; dsa_compact<true>(W + 1024 + q * DSA_QB, hist, cq, lane, nc);
                    cnt0 = q == 0 ? 256 : cnt0; cnt1 = q == 1 ? 256 : cnt1; cnt2 = q == 2 ? 256 : cnt2; cnt3 = q == 3 ? 256 : cnt3; } }
        }
        {
            unsigned short idxr[4][4];
#pragma unroll
            for (int q = 0; q < 4; ++q) { const int Lq = q == 0 ? cnt0 : q == 1 ? cnt1 : q == 2 ? cnt2 : cnt3;
#pragma unroll
                for (int i = 0; i < 4; ++i) { const int e = i * 64 + lane; idxr[q][i] = 0; if (e < Lq) idxr[q][i] = ((LAS unsigned short*)(W + 1024 + DSA_QB * q + DSA_IOFF))[e]; } }
            asm volatile("s_waitcnt lgkmcnt(0)" ::: "memory");
#pragma unroll
            for (int q = 0; q < 4; ++q)
#pragma unroll
                for (int i = 0; i < 4; ++i) ((LAS unsigned short*)W)[q * 256 + i * 64 + lane] = idxr[q][i];
            asm volatile("s_waitcnt lgkmcnt(0)" ::: "memory");
        }
        {
            __builtin_amdgcn_s_setprio(1);
            const LAS unsigned short* list16 = (const LAS unsigned short*)W;
            LAS unsigned char* Vs = W + 2048;
            const int hd = lane & 15, quad = lane >> 4, q4 = (lane & 15) >> 2, p4 = lane & 3;
#pragma unroll 1
            for (int q = 0; q < 4; ++q) {
                const int L = q == 0 ? cnt0 : q == 1 ? cnt1 : q == 2 ? cnt2 : cnt3;
                const int t = tw + q;
                bf16x8 qb[2];
#pragma unroll
                for (int ks = 0; ks < 2; ++ks) { qb[ks] = (bf16x8){0, 0, 0, 0, 0, 0, 0, 0}; if (hd < 8) qb[ks] = *(const bf16x8*)(dq + (tokb + t) * 512 + hd * 64 + 32 * ks + 8 * quad); }
                f32x4 O[4];
#pragma unroll
                for (int dt = 0; dt < 4; ++dt) O[dt] = (f32x4){0.f, 0.f, 0.f, 0.f};
                float mrun = -INFINITY, lrun = 0.f;
#pragma unroll 1
                for (int half = 0; half < 2; ++half) {
                    const LAS unsigned short* ml = list16 + q * 256 + 128 * half;
                    asm volatile("s_waitcnt lgkmcnt(0)" ::: "memory");
                    u32x4 vreg[16]; bf16x8 kreg[8][2];
#pragma unroll
                    for (int c = 0; c < 8; ++c) { const unsigned tk = ml[16 * c + hd]; const bf16* kp2 = dk + (tokb + tk) * 64 + 8 * quad;
                        kreg[c][0] = *(const bf16x8*)kp2; kreg[c][1] = *(const bf16x8*)(kp2 + 32); }
#pragma unroll
                    for (int it = 0; it < 16; ++it) { const int idx = it * 64 + lane, r = idx >> 3, cc = idx & 7; const unsigned tk = ml[r];
                        vreg[it] = *(const u32x4*)(dv + (tokb + tk) * 64 + 8 * cc); }
                    f32x4 Sc[8];
#pragma unroll
                    for (int c = 0; c < 8; ++c) { f32x4 z = {0.f, 0.f, 0.f, 0.f}; z = MFMA16BF(kreg[c][0], qb[0], z); Sc[c] = MFMA16BF(kreg[c][1], qb[1], z); }
#pragma unroll
                    for (int it = 0; it < 16; ++it) { const int idx = it * 64 + lane, r = idx >> 3, cc = idx & 7; *(LAS u32x4*)(Vs + r * 128 + cc * 16) = vreg[it]; }
                    float mloc = -INFINITY;
#pragma unroll
                    for (int c = 0; c < 8; ++c)
#pragma unroll
                        for (int e = 0; e < 4; ++e) { const int li = 128 * half + 16 * c + 4 * quad + e; float xv = Sc[c][e] * (0.125f * LOG2E); if (li >= L) xv = -INFINITY; Sc[c][e] = xv; mloc = fmaxf(mloc, xv); }
                    mloc = fmaxf(mloc, __shfl_xor(mloc, 16)); mloc = fmaxf(mloc, __shfl_xor(mloc, 32));
                    const float mnew = fmaxf(mrun, mloc);
                    const float fsc = __builtin_amdgcn_exp2f(mrun - mnew);
                    mrun = mnew;
                    float lsum = 0.f;
#pragma unroll
                    for (int c = 0; c < 8; ++c)
#pragma unroll
                        for (int e = 0; e < 4; ++e) { const float p = __builtin_amdgcn_exp2f(Sc[c][e] - mnew); Sc[c][e] = p; lsum += p; }
                    lsum += __shfl_xor(lsum, 16); lsum += __shfl_xor(lsum, 32);
                    lrun = lrun * fsc + lsum;
#pragma unroll
                    for (int e = 0; e < 4; ++e) { const float f = __shfl(fsc, (4 * quad + e) & 15);
#pragma unroll
                        for (int dt = 0; dt < 4; ++dt) O[dt][e] *= f; }
                    asm volatile("s_waitcnt lgkmcnt(0)" ::: "memory");
#pragma unroll
                    for (int kk = 0; kk < 4; ++kk) {
                        const int c0 = 2 * kk;
                        u32x4 pw; pw.x = pkbf(Sc[c0][0], Sc[c0][1]); pw.y = pkbf(Sc[c0][2], Sc[c0][3]); pw.z = pkbf(Sc[c0 + 1][0], Sc[c0 + 1][1]); pw.w = pkbf(Sc[c0 + 1][2], Sc[c0 + 1][3]);
                        const bf16x8 pa = __builtin_bit_cast(bf16x8, pw);
#pragma unroll
                        for (int dt = 0; dt < 4; ++dt) {
                            const v4i16_t lo = trrd(Vs + (32 * kk + 4 * quad + q4) * 128 + (16 * dt + 4 * p4) * 2);
                            const v4i16_t hi4 = trrd(Vs + (32 * kk + 16 + 4 * quad + q4) * 128 + (16 * dt + 4 * p4) * 2);
                            const bf16x8 vb = (bf16x8){lo[0], lo[1], lo[2], lo[3], hi4[0], hi4[1], hi4[2], hi4[3]};
                            O[dt] = MFMA16BF(pa, vb, O[dt]);
                        }
                    }
                }
#pragma unroll
                for (int e = 0; e < 4; ++e) { const float l = __shfl(lrun, (4 * quad + e) & 15); const float rl = 1.f / l;
                    if (quad < 2) {
#pragma unroll
                        for (int dt = 0; dt < 4; ++dt) attn[(tokb + t) * 1024 + (4 * quad + e) * 64 + 16 * dt + hd] = (bf16)(pkbf(O[dt][e] * rl, 0.f) & 0xffffu); } }
            }
            asm volatile("s_waitcnt lgkmcnt(0)" ::: "memory");
            __builtin_amdgcn_s_setprio(0);
        }
    }
}

__device__ __forceinline__ void swa_phase(LAS unsigned char* lds, const bf16* sq, const bf16* sk, const bf16* sv, const float* sinks, bf16* attn, int bid, int G, int wid, int lane) {
    asm volatile("" : "+v"(lane));
    LAS unsigned char* Vs = lds + wid * 4096;
    const int r32 = lane & 31, hi = lane >> 5;
    const int g16 = (lane >> 4) & 1, q4 = (lane & 15) >> 2, p4 = lane & 3;
    constexpr int NU = NB * 8 * (SEQ / 32);
    for (int u = bid * NWAVES + wid; u < NU; u += G * NWAVES) {
        const int qb = u & 255, hq = (u >> 8) & 7, b = u >> 11, hk = hq >> 2;
        const int q0 = 32 * qb; const size_t tokb = (size_t)b * SEQ;
        const float sink2 = sinks[hq] * LOG2E;
        bf16x8 qf[4];
#pragma unroll
        for (int s = 0; s < 4; ++s) qf[s] = *(const bf16x8*)(sq + (tokb + q0 + r32) * 512 + hq * 64 + 16 * s + 8 * hi);
        u32x4 vraw[5][4];
#pragma unroll
        for (int c = 0; c < 5; ++c)
#pragma unroll
            for (int it = 0; it < 4; ++it) { const int idx = it * 64 + lane, rr = idx >> 3, cc = idx & 7; int kt = q0 - 128 + 32 * c + rr; kt = kt < 0 ? 0 : kt;
                vraw[c][it] = *(const u32x4*)(sv + (tokb + kt) * 128 + hk * 64 + 8 * cc); }
        f32x16 Sc[5];
#pragma unroll
        for (int c = 0; c < 5; ++c) { int kt = q0 - 128 + 32 * c + r32; kt = kt < 0 ? 0 : kt; const bf16* kp = sk + (tokb + kt) * 128 + hk * 64 + 8 * hi;
            f32x16 acc = {};
#pragma unroll
            for (int s = 0; s < 4; ++s) acc = MFMA32BF(*(const bf16x8*)(kp + 16 * s), qf[s], acc);
            Sc[c] = acc; }
        const int qpos = q0 + r32;
        float m = sink2;
#pragma unroll
        for (int c = 0; c < 5; ++c)
#pragma unroll
            for (int e = 0; e < 16; ++e) { const int kpos = q0 - 128 + 32 * c + crow(e, hi); const int diff = qpos - kpos; float xv = Sc[c][e] * (0.125f * LOG2E);
                if (!(diff >= 0 && diff < 128 && kpos >= 0)) xv = -INFINITY; Sc[c][e] = xv; m = fmaxf(m, xv); }
        m = fmaxf(m, __shfl_xor(m, 32));
        float l = 0.f;
#pragma unroll
        for (int c = 0; c < 5; ++c)
#pragma unroll
            for (int e = 0; e < 16; ++e) { const float p = __builtin_amdgcn_exp2f(Sc[c][e] - m); Sc[c][e] = p; l += p; }
        l += __shfl_xor(l, 32);
        l += __builtin_amdgcn_exp2f(sink2 - m);
        f32x16 O[2]; O[0] = (f32x16){}; O[1] = (f32x16){};
#pragma unroll
        for (int c = 0; c < 5; ++c) {
            asm volatile("s_waitcnt lgkmcnt(0)" ::: "memory");
#pragma unroll
            for (int it = 0; it < 4; ++it) { const int idx = it * 64 + lane, rr = idx >> 3, cc = idx & 7; *(LAS u32x4*)(Vs + rr * 128 + cc * 16) = vraw[c][it]; }
            asm volatile("s_waitcnt lgkmcnt(0)" ::: "memory");
#pragma unroll
            for (int s2 = 0; s2 < 2; ++s2) {
                u32x4 pw; pw.x = pkbf(Sc[c][8 * s2], Sc[c][8 * s2 + 1]); pw.y = pkbf(Sc[c][8 * s2 + 2], Sc[c][8 * s2 + 3]); pw.z = pkbf(Sc[c][8 * s2 + 4], Sc[c][8 * s2 + 5]); pw.w = pkbf(Sc[c][8 * s2 + 6], Sc[c][8 * s2 + 7]);
                const bf16x8 pb = __builtin_bit_cast(bf16x8, pw);
#pragma unroll
                for (int dt = 0; dt < 2; ++dt) {
                    const v4i16_t lo = trrd(Vs + (16 * s2 + 4 * hi + q4) * 128 + (32 * dt + 16 * g16 + 4 * p4) * 2);
                    const v4i16_t hi4 = trrd(Vs + (16 * s2 + 8 + 4 * hi + q4) * 128 + (32 * dt + 16 * g16 + 4 * p4) * 2);
                    const bf16x8 va = (bf16x8){lo[0], lo[1], lo[2], lo[3], hi4[0], hi4[1], hi4[2], hi4[3]};
                    O[dt] = MFMA32BF(va, pb, O[dt]);
                }
            }
        }
        const float rl = 1.f / l;
        bf16* op = attn + (tokb + q0 + r32) * 1024 + 512 + hq * 64;
#pragma unroll
        for (int dt = 0; dt < 2; ++dt)
#pragma unroll
            for (int a = 0; a < 4; ++a) { u32x2 w; w.x = pkbf(O[dt][4 * a] * rl, O[dt][4 * a + 1] * rl); w.y = pkbf(O[dt][4 * a + 2] * rl, O[dt][4 * a + 3] * rl);
                *(u32x2*)(op + 32 * dt + 8 * a + 4 * hi) = w; }
    }
    asm volatile("s_waitcnt lgkmcnt(0)" ::: "memory");
}

__device__ __forceinline__ void xattn_phase(LAS unsigned char* lds, const bf16* qmem, const bf16* memkv, const bf16* memkf, bf16* catt, int bid, int G, int tid, int wid, int lane, int usel = -1) {
    asm volatile("" : "+v"(lane), "+v"(tid));
    constexpr int VROW = 320;
    const int r32 = lane & 31, hi = lane >> 5;
    const int g16 = (lane >> 4) & 1, q4 = (lane & 15) >> 2, p4 = lane & 3;
    for (int u = (usel >= 0 ? usel : bid); u < 512; u += (usel >= 0 ? 512 : G)) {
        const int qt = u & 31, head = (u >> 5) & 3, b = u >> 7;
        const size_t tok0 = (size_t)b * SEQ + 256 * qt + 32 * wid;
        const bf16* kbase = memkv + (size_t)(b * MEMT) * 2048 + head * 256;
        const bf16* kfb = memkf + (size_t)(b * 4 + head) * 128 * 512 + lane * 8;
        f32x16 Sc[8];
#pragma unroll
        for (int c = 0; c < 8; ++c) Sc[c] = (f32x16){};
#pragma unroll 2
        for (int s = 0; s < 16; ++s) {
            const bf16x8 qf = *(const bf16x8*)(qmem + (tok0 + r32) * 1024 + head * 256 + 16 * s + 8 * hi);
#pragma unroll
            for (int c = 0; c < 8; ++c) { const bf16x8 kf = *(const bf16x8*)(kfb + (size_t)(c * 16 + s) * 512); Sc[c] = MFMA32BF(kf, qf, Sc[c]); }
        }
        float m = -INFINITY;
#pragma unroll
        for (int c = 0; c < 8; ++c)
#pragma unroll
            for (int e = 0; e < 16; ++e) { const float xv = Sc[c][e] * LOG2E; Sc[c][e] = xv; m = fmaxf(m, xv); }
        m = fmaxf(m, __shfl_xor(m, 32));
        float l = 0.f;
#pragma unroll
        for (int c = 0; c < 8; ++c)
#pragma unroll
            for (int e = 0; e < 16; ++e) { const float p = __builtin_amdgcn_exp2f(Sc[c][e] - m); Sc[c][e] = p; l += p; }
        l += __shfl_xor(l, 32);
        const float rl = 1.f / l;
        bf16x8 pb[8][2];
#pragma unroll
        for (int c = 0; c < 8; ++c)
#pragma unroll
            for (int s2 = 0; s2 < 2; ++s2) { u32x4 pw; pw.x = pkbf(Sc[c][8 * s2], Sc[c][8 * s2 + 1]); pw.y = pkbf(Sc[c][8 * s2 + 2], Sc[c][8 * s2 + 3]); pw.z = pkbf(Sc[c][8 * s2 + 4], Sc[c][8 * s2 + 5]); pw.w = pkbf(Sc[c][8 * s2 + 6], Sc[c][8 * s2 + 7]);
                pb[c][s2] = __builtin_bit_cast(bf16x8, pw); }
#pragma unroll 1
        for (int dh = 0; dh < 2; ++dh) {
            __syncthreads();
#pragma unroll
            for (int it = 0; it < 8; ++it) { const int idx = it * NTHR + tid, rr = idx >> 4, cc = idx & 15;
                const u32x4 v = *(const u32x4*)(kbase + (size_t)rr * 2048 + 1024 + 128 * dh + 8 * cc); *(LAS u32x4*)(lds + rr * VROW + cc * 16) = v; }
            __syncthreads();
            f32x16 O[4];
#pragma unroll
            for (int dt = 0; dt < 4; ++dt) O[dt] = (f32x16){};
#pragma unroll
            for (int c = 0; c < 8; ++c)
#pragma unroll
                for (int s2 = 0; s2 < 2; ++s2)
#pragma unroll
                    for (int dt = 0; dt < 4; ++dt) {
                        const v4i16_t lo = trrd(lds + (32 * c + 16 * s2 + 4 * hi + q4) * VROW + (32 * dt + 16 * g16 + 4 * p4) * 2);
                        const v4i16_t hi4 = trrd(lds + (32 * c + 16 * s2 + 8 + 4 * hi + q4) * VROW + (32 * dt + 16 * g16 + 4 * p4) * 2);
                        const bf16x8 va = (bf16x8){lo[0], lo[1], lo[2], lo[3], hi4[0], hi4[1], hi4[2], hi4[3]};
                        O[dt] = MFMA32BF(va, pb[c][s2], O[dt]);
                    }
            bf16* op = catt + (tok0 + r32) * 1024 + head * 256 + 128 * dh;
#pragma unroll
            for (int dt = 0; dt < 4; ++dt)
#pragma unroll
                for (int a = 0; a < 4; ++a) { u32x2 w; w.x = pkbf(O[dt][4 * a] * rl, O[dt][4 * a + 1] * rl); w.y = pkbf(O[dt][4 * a + 2] * rl, O[dt][4 * a + 3] * rl);
                    *(u32x2*)(op + 32 * dt + 8 * a + 4 * hi) = w; }
        }
    }
    __syncthreads();
}

#define XB_TMO      128
#define XB_XCNT(j)  (256  + 64 * (j))
#define XB_XSUB(j)  (1280 + 64 * (j))
#define XB_XGEN(j)  (2304 + 64 * (j))
#define XB_TOP      3328
#define XB_TOPGEN   3392
#define XCD_BAR_WORDS 3456
#define XB_SPIN_CAP (1u << 18)

__device__ __forceinline__ unsigned xb_ld(unsigned* p)              { return __hip_atomic_load(p, __ATOMIC_RELAXED, __HIP_MEMORY_SCOPE_AGENT); }
__device__ __forceinline__ unsigned xb_add(unsigned* p, unsigned v) { return __hip_atomic_fetch_add(p, v, __ATOMIC_RELAXED, __HIP_MEMORY_SCOPE_AGENT); }
__device__ __forceinline__ unsigned xb_xcc_id() { return (unsigned)__builtin_amdgcn_s_getreg((3 << 11) | 20) & 0xFu; }
#define XB_SPIN(cond, bar) do { unsigned _sp = 0; while (cond) { __builtin_amdgcn_s_sleep(1); \
    if ((++_sp & 255u) == 0u) { if (xb_ld(&(bar)[XB_TMO])) break; if (_sp > XB_SPIN_CAP) { atomicAdd(&(bar)[XB_TMO], 1u); break; } } } } while (0)

struct XcdBarrier {
    unsigned* bar; unsigned x;
    volatile LAS unsigned* st;
};

__device__ __forceinline__ XcdBarrier xcd_barrier_post(unsigned* bar, volatile LAS unsigned* st) {
    XcdBarrier b; b.bar = bar; b.x = xb_xcc_id(); b.st = st;
    if (threadIdx.x == 0) (void)xb_add(&bar[XB_XCNT(b.x)], 1u);
    return b;
}
__device__ __forceinline__ void xcd_barrier_complete(unsigned* bar, unsigned x, unsigned& nloc, unsigned& nx) {
    const unsigned G = gridDim.x * gridDim.y * gridDim.z;
    unsigned sum, cnt, mine, sp = 0u;
    for (;;) {
        sum = 0u; cnt = 0u; mine = 0u;
#pragma unroll
        for (unsigned j = 0; j < 16; ++j) { const unsigned c = xb_ld(&bar[XB_XCNT(j)]); sum += c; cnt += (c > 0u) ? 1u : 0u; mine = (j == x) ? c : mine; }
        if (sum == G) break;
        __builtin_amdgcn_s_sleep(1);
        if ((++sp & 255u) == 0u) { if (xb_ld(&bar[XB_TMO])) break; if (sp > XB_SPIN_CAP) { atomicAdd(&bar[XB_TMO], 1u); break; } }
    }
    nloc = mine > 0u ? mine : 1u; nx = cnt > 0u ? cnt : 1u;
}

__device__ __forceinline__ void xcd_barrier(const XcdBarrier& b) {
    asm volatile("s_waitcnt vmcnt(0)" ::: "memory");
    __syncthreads();
    if (threadIdx.x == 0) {
        unsigned* bar = b.bar;
        __builtin_amdgcn_s_waitcnt(0);
        unsigned nloc = b.st[0], nx = b.st[1];
        if (nloc == 0u) { xcd_barrier_complete(bar, b.x, nloc, nx); b.st[0] = nloc; b.st[1] = nx; }
        const unsigned old = xb_add(&bar[XB_XSUB(b.x)], 1u);
        const unsigned gen = old / nloc;
        if (old + 1u == (gen + 1u) * nloc) {
            __builtin_amdgcn_fence(__ATOMIC_RELEASE, "agent");
            asm volatile("s_waitcnt vmcnt(0)" ::: "memory");
            const unsigned og = xb_add(&bar[XB_TOP], 1u);
            const unsigned tg = og / nx;
            if (og + 1u == (tg + 1u) * nx) xb_add(&bar[XB_TOPGEN], 1u);
            else XB_SPIN(xb_ld(&bar[XB_TOPGEN]) == tg, bar);
            __builtin_amdgcn_fence(__ATOMIC_ACQUIRE, "agent");
            xb_add(&bar[XB_XGEN(b.x)], 1u);
            asm volatile("s_waitcnt vmcnt(0)" ::: "memory");
        } else {
            XB_SPIN(xb_ld(&bar[XB_XGEN(b.x)]) == gen, bar);
            __builtin_amdgcn_fence(__ATOMIC_ACQUIRE, "agent");
            asm volatile("s_waitcnt vmcnt(0)" ::: "memory");
        }
    }
    __syncthreads();
}

#ifndef REP_P1
#define REP_P1 1
#endif
#ifndef REP_SWA
#define REP_SWA 1
#endif
#ifndef REP_DSA
#define REP_DSA 1
#endif
#ifndef REP_XA
#define REP_XA 1
#endif
#ifndef REP_LN
#define REP_LN 1
#endif
#ifndef REP_FF
#define REP_FF 1
#endif
#ifndef REP_P0
#define REP_P0 1
#endif
#define PHASE_PTRS \
    __attribute__((address_space(1))) unsigned char* ws0_ = (__attribute__((address_space(1))) unsigned char*)P.ws; asm volatile("" : "+s"(ws0_)); unsigned char* ws = (unsigned char*)ws0_;     \
    bf16* w_in_t = (bf16*)(ws + WS_WIN); bf16* w_o_t = (bf16*)(ws + WS_WO); bf16* wq_t = (bf16*)(ws + WS_WQ); bf16* wkv_t = (bf16*)(ws + WS_WKV); \
    bf16* wom_t = (bf16*)(ws + WS_WOM); bf16* wup_t = (bf16*)(ws + WS_WUP); bf16* wdn_t = (bf16*)(ws + WS_WDN); \
    bf16* memb = (bf16*)(ws + WS_MEMB); bf16* memkv = (bf16*)(ws + WS_MEMKV); bf16* memkf = (bf16*)(ws + WS_MEMKF); (void)memkf; \
    float* cosT = (float*)(ws + WS_COS); float* sinT = (float*)(ws + WS_SIN); \
    f32x2* st1 = (f32x2*)(ws + WS_ST1); f32x2* st2 = (f32x2*)(ws + WS_ST2); \
    bf16* ra = (bf16*)(ws + WS_RA); \
    bf16* dq = (bf16*)(ws + WS_DQ); bf16* sqb = (bf16*)(ws + WS_SQ); _Float16* iq = (_Float16*)(ws + WS_IQ); bf16* dk = (bf16*)(ws + WS_DK); bf16* dv = (bf16*)(ws + WS_DV); \
    _Float16* ik = (_Float16*)(ws + WS_IK); bf16* skb = (bf16*)(ws + WS_SK); bf16* svb = (bf16*)(ws + WS_SV); float* iw = (float*)(ws + WS_IW); \
    bf16* y1 = (bf16*)(ws + WS_RC); bf16* y2 = (bf16*)(ws + WS_RB);     \
    bf16* hb1 = (bf16*)(ws + WS_RD); bf16* catt = (bf16*)(ws + WS_RE); bf16* ffb = (bf16*)(ws + WS_RC); \
    (void)w_in_t; (void)w_o_t; (void)wq_t; (void)wkv_t; (void)wom_t; (void)wup_t; (void)wdn_t; (void)memb; (void)memkv; (void)cosT; (void)sinT; (void)st1; (void)st2; (void)ra; \
    (void)dq; (void)sqb; (void)iq; (void)dk; (void)dv; (void)ik; (void)skb; (void)svb; (void)iw; (void)y1; (void)y2; (void)hb1; (void)catt; (void)ffb;
__global__ void __launch_bounds__(NTHR, 2) fwd_megakernel(Params P) {
    extern __shared__ __attribute__((aligned(16))) unsigned char lds_raw[];
    cg::grid_group grid = cg::this_grid();
    LAS unsigned char* lds = (LAS unsigned char*)lds_raw;
    const int tid = threadIdx.x, lane = tid & 63, wid = __builtin_amdgcn_readfirstlane(tid >> 6);
    const int bid = blockIdx.x, G = gridDim.x;
    const int gw = bid * NWAVES + wid, NGW = G * NWAVES;

    volatile LAS unsigned* MISC = (volatile LAS unsigned*)(lds + MISC_OFF);
    if (tid < 32) MISC[tid] = 0u;
    __syncthreads();
    const XcdBarrier xbar = xcd_barrier_post((unsigned*)P.ws, MISC + 8);
    {
    PHASE_PTRS
    for (int rep = 0; rep < REP_P0; ++rep) { p0_prologue(P, lds, bid, G, tid, wid, lane); __syncthreads(); }
    }
    grid.sync();
    {
    PHASE_PTRS
    for (int rep = 0; rep < REP_P1; ++rep)
    { pg8::Gemm g{ra, w_in_t, MTOK, NPROJ, DM}; pg8::StaticOrder S; S.init(MTOK, NPROJ, G, bid);
      pg8::EpiInProj E{P.b_in, cosT, sinT, dq, dk, dv, sqb, skb, svb, iq, ik, iw};
      pg8::gemm_phase<pg8::EpiInProj, pg8::StaticOrder, true, true>(lds, g, S, E); }
    }
    xcd_barrier(xbar);
    {
    PHASE_PTRS
    for (int rep = 0; rep < REP_SWA; ++rep) { swa_phase(lds, sqb, skb, svb, P.sinks, ra, bid, G, wid, lane); __syncthreads(); }
    for (int rep = 0; rep < REP_DSA; ++rep) dsa_phase(lds, iq, ik, iw, dq, dk, dv, ra, bid, G, tid, wid, lane);
    }
    xcd_barrier(xbar);
    {
    PHASE_PTRS
    { pg8::Gemm g{ra, w_o_t, MTOK, DM, DM}; pg8::StaticOrder S; S.init(MTOK, DM, G, bid);
      pg8::EpiRes<false, float, bf16> E{P.x, y1, nullptr, nullptr, nullptr, ALPHA};
      pg8::gemm_phase<pg8::EpiRes<false, float, bf16>, pg8::StaticOrder, true, true>(lds, g, S, E); }
    }
    xcd_barrier(xbar);
    {
    PHASE_PTRS
    if (G > 64) {
      if (bid < 32) { pg8::Gemm g{memb, wkv_t, MROWS, 2048, DM}; pg8::StaticOrder S; S.init(MROWS, 2048, 32, bid);
        pg8::EpiMemKV E{memkf, memkv};
        pg8::gemm_phase<pg8::EpiMemKV, pg8::StaticOrder, true, true>(lds, g, S, E); }
      else ln_pass(y1, P.ln1g, P.ln1b, hb1, st1, nullptr, (bid - 32) * NWAVES + wid, (G - 32) * NWAVES, lane);
    } else {
      { pg8::Gemm g{memb, wkv_t, MROWS, 2048, DM}; pg8::StaticOrder S; S.init(MROWS, 2048, G, bid);
        pg8::EpiMemKV E{memkf, memkv};
        pg8::gemm_phase<pg8::EpiMemKV, pg8::StaticOrder, true, true>(lds, g, S, E); }
      ln_pass(y1, P.ln1g, P.ln1b, hb1, st1, nullptr, gw, NGW, lane);
    }
    }
    xcd_barrier(xbar);
    {
    PHASE_PTRS
    { pg8::Gemm g{hb1, wq_t, MTOK, DM, DM}; pg8::StaticOrder S; S.init(MTOK, DM, G, bid);
      pg8::EpiBf16<0> E{ra, DM, 0.0625f};
#pragma unroll 1
      for (int i = 0; ; ++i) { pg8::Unit u; if (!S.next(i, u)) break;
          pg8::OneUnit S1{u};
          pg8::gemm_phase<pg8::EpiBf16<0>, pg8::OneUnit, true, true>(lds, g, S1, E);
          asm volatile("s_waitcnt vmcnt(0)" ::: "memory"); __syncthreads();
          xattn_phase(lds, ra, memkv, memkf, catt, bid, G, tid, wid, lane, ((u.pm >> 5) << 7) | (u.pn << 5) | (u.pm & 31)); } }
    }
    xcd_barrier(xbar);
    {
    PHASE_PTRS
    { pg8::Gemm g{catt, wom_t, MTOK, DM, DM}; pg8::StaticOrder S; S.init(MTOK, DM, G, bid);
      pg8::EpiRes<true, bf16, bf16> E{y1, y2, st1, P.ln1g, P.ln1b, ALPHA};
      pg8::gemm_phase<pg8::EpiRes<true, bf16, bf16>, pg8::StaticOrder, true, true>(lds, g, S, E); }
    }
    xcd_barrier(xbar);
    {
    PHASE_PTRS
    ln_pass(y2, P.ln2g, P.ln2b, ra, st2, nullptr, gw, NGW, lane);
    }
    xcd_barrier(xbar);
    {
    PHASE_PTRS
    for (int rep = 0; rep < REP_FF; ++rep)
    { pg8::Gemm g{ra, wup_t, MTOK, FF, DM}; pg8::StaticOrder S; S.init(MTOK, FF, G, bid);
      pg8::EpiBf16<2> E{ffb, FF, 1.f};
      pg8::gemm_phase<pg8::EpiBf16<2>, pg8::StaticOrder, true, true>(lds, g, S, E); }
    }
    xcd_barrier(xbar);
    {
    PHASE_PTRS
    { pg8::Gemm g{ffb, wdn_t, MTOK, DM, FF}; pg8::StaticOrder S; S.init(MTOK, DM, G, bid);
      pg8::EpiRes<true, bf16, bf16> E{y2, ra, st2, P.ln2g, P.ln2b, ALPHA};
      pg8::gemm_phase<pg8::EpiRes<true, bf16, bf16>, pg8::StaticOrder, true, true>(lds, g, S, E); }
    }
    xcd_barrier(xbar);
    {
    PHASE_PTRS
    ln_pass(ra, P.ln3g, P.ln3b, nullptr, nullptr, P.out, gw, NGW, lane);
    }
}

extern "C" void kernel_launch(void* const* d_in, const int* in_sizes, int n_in, void* d_out, int out_size, void* d_ws, size_t ws_size, hipStream_t stream) {
    static int grid = 0;
    if (grid == 0) {
        if (n_in != 19 || in_sizes[0] != MTOK * DM || out_size != MTOK * DM || ws_size < WS_END) { fprintf(stderr, "kernel_launch: unexpected shapes (n_in %d, in0 %d, out %d, ws %zu)\n", n_in, n_in > 0 ? in_sizes[0] : -1, out_size, ws_size); grid = -1; return; }
        int dev = 0, cus = 0, per_cu = 0;
        hipGetDevice(&dev);
        hipDeviceGetAttribute(&cus, hipDeviceAttributeMultiprocessorCount, dev);
        if (hipFuncSetAttribute((const void*)fwd_megakernel, hipFuncAttributeMaxDynamicSharedMemorySize, LDS_BYTES) != hipSuccess) { fprintf(stderr, "kernel_launch: hipFuncSetAttribute failed\n"); grid = -1; return; }
        if (hipOccupancyMaxActiveBlocksPerMultiprocessor(&per_cu, (const void*)fwd_megakernel, NTHR, LDS_BYTES) != hipSuccess || per_cu < 1) { fprintf(stderr, "kernel_launch: occupancy query says %d blocks per CU\n", per_cu); per_cu = 1; }
        (void)hipGetLastError();
        grid = cus * 1;
        fprintf(stderr, "kernel_launch: cus %d per_cu %d grid %d\n", cus, per_cu, grid);
    }
    if (grid < 0) return;
    Params p{};
    p.x = (const float*)d_in[0]; p.mem = (const float*)d_in[1]; p.pos = (const int*)d_in[2]; p.w_in = (const float*)d_in[3]; p.b_in = (const float*)d_in[4];
    p.sinks = (const float*)d_in[5]; p.w_o = (const float*)d_in[6]; p.ln1g = (const float*)d_in[7]; p.ln1b = (const float*)d_in[8];
    p.wq = (const float*)d_in[9]; p.wk = (const float*)d_in[10]; p.wv = (const float*)d_in[11]; p.wom = (const float*)d_in[12];
    p.ln2g = (const float*)d_in[13]; p.ln2b = (const float*)d_in[14]; p.wup = (const float*)d_in[15]; p.wdn = (const float*)d_in[16];
    p.ln3g = (const float*)d_in[17]; p.ln3b = (const float*)d_in[18];
    p.out = (float*)d_out; p.ws = (unsigned char*)d_ws;
    if (hipMemsetAsync(d_ws, 0, 16384, stream) != hipSuccess) { fprintf(stderr, "kernel_launch: memset failed\n"); return; }
    void* args[] = {&p};
    hipError_t e = hipLaunchCooperativeKernel((const void*)fwd_megakernel, dim3(grid), dim3(NTHR), args, LDS_BYTES, stream);
    if (e != hipSuccess) fprintf(stderr, "kernel_launch: cooperative launch failed: %s (grid %d)\n", hipGetErrorString(e), grid);
}
```
